# Optimizing an MI355X kernel written in HIP

```python
import math
import jax, jax.numpy as jnp
from jax import lax
import numpy as np

D_MODEL = 1024
BATCH = 4
SEQ = 8192
DEPTH = 2

HEAD_DIM = 64
SWA_HEADS = 4
SWA_KV_HEADS = 2
SWA_WINDOW = 128
SWA_BLOCK = 128
MOBA_HEADS = 4
MOBA_BLOCK = 256
MOBA_TOPK = 3
MOBA_QCHUNK = 64
DN_HEADS = 4
DN_HEAD_DIM = 128
DN_CONV = 4
DN_CHUNK = 64
D_FF = 2816
FFN_CONV = 3

NORM_EPS = 1e-6
NEG_INF = -1e30

SWA_Q = SWA_HEADS * HEAD_DIM
SWA_KV = SWA_KV_HEADS * HEAD_DIM
MOBA_W = MOBA_HEADS * HEAD_DIM
DN_W = DN_HEADS * DN_HEAD_DIM
MIX_WIDTH = SWA_Q + MOBA_W + DN_W
IN_SPLIT_SIZES = (SWA_Q, SWA_KV, SWA_KV, MOBA_W, MOBA_W, MOBA_W, 3 * DN_W, DN_W, DN_HEADS, DN_HEADS)
IN_WIDTH = SWA_Q + 2 * SWA_KV + 3 * MOBA_W + 4 * DN_W + 2 * DN_HEADS

kernel_name = 'hybrid_swa_moba_gdn_block'


def rms_norm(x, w):
    xf = x.astype(jnp.float32)
    y = xf * lax.rsqrt(jnp.mean(xf * xf, axis=-1, keepdims=True) + NORM_EPS)
    return (y * w.astype(jnp.float32)).astype(x.dtype)


def l2_norm(x):
    return x * lax.rsqrt(jnp.sum(x * x, axis=-1, keepdims=True) + NORM_EPS)


def alibi_slopes():
    n = SWA_HEADS + MOBA_HEADS
    s = 2.0 ** (-8.0 * jnp.arange(1, n + 1, dtype=jnp.float32) / n)
    return s[0::2], s[1::2]


def causal_depthwise_conv(x, w):
    K = w.shape[0]
    S = x.shape[1]
    xp = jnp.pad(x, ((0, 0), (K - 1, 0), (0, 0)))
    y = xp[:, 0:S] * w[0]
    for i in range(1, K):
        y = y + xp[:, i:i + S] * w[i]
    return y


def swa_sink_attention(q, k, v, sinks, slopes):
    B, S, Hq, d = q.shape
    Hkv = k.shape[2]
    G = Hq // Hkv
    nb = S // SWA_BLOCK
    qb = q.reshape(B, nb, SWA_BLOCK, Hkv, G, d)
    kb = k.reshape(B, nb, SWA_BLOCK, Hkv, d)
    vb = v.reshape(B, nb, SWA_BLOCK, Hkv, d)

    def with_prev(t):
        prev = jnp.pad(t, ((0, 0), (1, 0), (0, 0), (0, 0), (0, 0)))[:, :-1]
        return jnp.concatenate([prev, t], axis=2)

    kk, vv = with_prev(kb), with_prev(vb)
    scores = jnp.einsum('bnqhgd,bnshd->bnhgqs', qb, kk).astype(jnp.float32) * (d ** -0.5)
    rel = jnp.arange(SWA_BLOCK)[:, None] + SWA_BLOCK - jnp.arange(2 * SWA_BLOCK)[None, :]
    kpos = (jnp.arange(nb) * SWA_BLOCK - SWA_BLOCK)[:, None] + jnp.arange(2 * SWA_BLOCK)[None, :]
    valid = ((rel >= 0) & (rel < SWA_WINDOW))[None] & (kpos >= 0)[:, None, :]
    m = slopes.astype(jnp.float32).reshape(Hkv, G)[:, :, None, None]
    scores = scores - m * rel.astype(jnp.float32)
    scores = jnp.where(valid[None, :, None, None], scores, NEG_INF)
    sink = sinks.astype(jnp.float32).reshape(Hkv, G)[:, :, None, None]
    mx = jnp.maximum(scores.max(axis=-1, keepdims=True), sink)
    p = jnp.exp(scores - mx)
    denom = p.sum(axis=-1, keepdims=True) + jnp.exp(sink - mx)
    probs = (p / denom).astype(v.dtype)
    out = jnp.einsum('bnhgqs,bnshd->bnqhgd', probs, vv)
    return out.reshape(B, S, Hq, d)


def moba_attention(q, k, v, slopes):
    B, S, H, d = q.shape
    S_pad = -(-S // MOBA_BLOCK) * MOBA_BLOCK
    pad = ((0, 0), (0, S_pad - S), (0, 0), (0, 0))
    q, k, v = jnp.pad(q, pad), jnp.pad(k, pad), jnp.pad(v, pad)
    nblk = S_pad // MOBA_BLOCK
    topk = min(MOBA_TOPK, nblk)
    kb = k.reshape(B, nblk, MOBA_BLOCK, H, d).transpose(0, 3, 1, 2, 4)
    vb = v.reshape(B, nblk, MOBA_BLOCK, H, d).transpose(0, 3, 1, 2, 4)
    k_mean = kb.astype(jnp.float32).mean(axis=3)
    nq = S_pad // MOBA_QCHUNK
    q_chunks = q.reshape(B, nq, MOBA_QCHUNK, H, d).transpose(1, 0, 3, 2, 4)
    bi = jnp.arange(B)[:, None, None, None]
    hi = jnp.arange(H)[None, :, None, None]
    m = slopes.astype(jnp.float32)[None, :, None, None]
    scale = d ** -0.5
    offs = jnp.arange(MOBA_BLOCK)

    def chunk_attend(args):
        qc, c = args
        t = c * MOBA_QCHUNK + jnp.arange(MOBA_QCHUNK)
        own = (c * MOBA_QCHUNK) // MOBA_BLOCK
        gate = jnp.einsum('bhqd,bhnd->bhqn', qc.astype(jnp.float32), k_mean)
        gate = jnp.where(jnp.arange(nblk) < own, gate, NEG_INF)
        _, idx = lax.top_k(gate, topk)
        sel_ok = idx < own
        k_sel = kb[bi, hi, idx]
        v_sel = vb[bi, hi, idx]
        s_sel = jnp.einsum('bhqd,bhqrsd->bhqrs', qc, k_sel).astype(jnp.float32) * scale
        kpos_sel = idx[..., None] * MOBA_BLOCK + offs
        s_sel = s_sel - m[..., None] * (t[:, None, None] - kpos_sel).astype(jnp.float32)
        s_sel = jnp.where(sel_ok[..., None], s_sel, NEG_INF).reshape(B, H, MOBA_QCHUNK, topk * MOBA_BLOCK)
        k_own = lax.dynamic_index_in_dim(kb, own, axis=2, keepdims=False)
        v_own = lax.dynamic_index_in_dim(vb, own, axis=2, keepdims=False)
        rel_own = t[:, None] - (own * MOBA_BLOCK + offs)[None, :]
        s_own = jnp.einsum('bhqd,bhsd->bhqs', qc, k_own).astype(jnp.float32) * scale - m * rel_own.astype(jnp.float32)
        s_own = jnp.where(rel_own >= 0, s_own, NEG_INF)
        probs = jax.nn.softmax(jnp.concatenate([s_sel, s_own], axis=-1), axis=-1).astype(v.dtype)
        p_sel = probs[..., :topk * MOBA_BLOCK].reshape(B, H, MOBA_QCHUNK, topk, MOBA_BLOCK)
        p_own = probs[..., topk * MOBA_BLOCK:]
        return (jnp.einsum('bhqrs,bhqrsd->bqhd', p_sel, v_sel)
                + jnp.einsum('bhqs,bhsd->bqhd', p_own, v_own))

    out = lax.map(chunk_attend, (q_chunks, jnp.arange(nq)))
    out = out.transpose(1, 0, 2, 3, 4).reshape(B, S_pad, H, d)
    return out[:, :S]


def gated_delta_rule(q, k, v, g, beta):
    B, S, H, dk = q.shape
    dv = v.shape[-1]
    C = DN_CHUNK
    nc = S // C

    def chunks(t):
        t = t.reshape((B, nc, C, H) + t.shape[3:])
        return jnp.moveaxis(t, 3, 1)

    q = chunks(q) * (dk ** -0.5)
    k = chunks(k)
    v = chunks(v)
    g = jnp.cumsum(chunks(g), axis=-1)
    beta = chunks(beta)
    causal = jnp.tril(jnp.ones((C, C), dtype=bool))
    strict = jnp.tril(jnp.ones((C, C), dtype=bool), -1)
    gdiff = g[..., :, None] - g[..., None, :]
    decay = jnp.where(causal, jnp.exp(jnp.where(causal, gdiff, 0.0)), 0.0)
    k_beta = k * beta[..., None]
    L = jnp.where(strict, jnp.einsum('bhnid,bhnjd->bhnij', k_beta, k) * decay, 0.0)
    rhs = jnp.concatenate([v * beta[..., None], k_beta * jnp.exp(g)[..., None]], axis=-1)
    sol = lax.linalg.triangular_solve(L + jnp.eye(C, dtype=L.dtype), rhs, left_side=True,
                                      lower=True, unit_diagonal=True)
    u, w = sol[..., :dv], sol[..., dv:]
    a_intra = jnp.einsum('bhnid,bhnjd->bhnij', q, k) * decay
    q_dec = q * jnp.exp(g)[..., None]
    g_last = g[..., -1]
    k_dec = k * jnp.exp(g_last[..., None] - g)[..., None]

    def step(state, xs):
        w_c, u_c, qd_c, a_c, kd_c, gl_c = xs
        v_new = u_c - jnp.einsum('bhcd,bhde->bhce', w_c, state)
        o = jnp.einsum('bhcd,bhde->bhce', qd_c, state) + jnp.einsum('bhij,bhje->bhie', a_c, v_new)
        state = state * jnp.exp(gl_c)[..., None, None] + jnp.einsum('bhcd,bhce->bhde', kd_c, v_new)
        return state, o

    xs = (jnp.moveaxis(w, 2, 0), jnp.moveaxis(u, 2, 0), jnp.moveaxis(q_dec, 2, 0),
          jnp.moveaxis(a_intra, 2, 0), jnp.moveaxis(k_dec, 2, 0), jnp.moveaxis(g_last, 2, 0))
    state0 = jnp.zeros((B, H, dk, dv), jnp.float32)
    _, o = lax.scan(step, state0, xs)
    return o.transpose(1, 0, 3, 2, 4).reshape(B, S, H, dv)


def hybrid_token_mixer(h, w_in, swa_sinks, dn_conv_w, dn_a_log, dn_dt_bias, dn_norm, w_out,
                       slopes_swa, slopes_moba):
    B, S, _ = h.shape
    proj = h @ w_in
    split_at = np.cumsum(IN_SPLIT_SIZES)[:-1].tolist()
    qa, ka, va, qb, kb, vb, qkv_c, z_c, b_c, a_c = jnp.split(proj, split_at, axis=-1)
    o_a = swa_sink_attention(qa.reshape(B, S, SWA_HEADS, HEAD_DIM),
                             ka.reshape(B, S, SWA_KV_HEADS, HEAD_DIM),
                             va.reshape(B, S, SWA_KV_HEADS, HEAD_DIM), swa_sinks, slopes_swa)
    o_b = moba_attention(qb.reshape(B, S, MOBA_HEADS, HEAD_DIM), kb.reshape(B, S, MOBA_HEADS, HEAD_DIM),
                         vb.reshape(B, S, MOBA_HEADS, HEAD_DIM), slopes_moba)
    qkv_c = jax.nn.silu(causal_depthwise_conv(qkv_c, dn_conv_w)).astype(jnp.float32)
    qc, kc, vc = jnp.split(qkv_c, 3, axis=-1)
    qc = l2_norm(qc.reshape(B, S, DN_HEADS, DN_HEAD_DIM))
    kc = l2_norm(kc.reshape(B, S, DN_HEADS, DN_HEAD_DIM))
    vc = vc.reshape(B, S, DN_HEADS, DN_HEAD_DIM)
    beta = jax.nn.sigmoid(b_c.astype(jnp.float32))
    g = -jnp.exp(dn_a_log.astype(jnp.float32)) * jax.nn.softplus(a_c.astype(jnp.float32) + dn_dt_bias.astype(jnp.float32))
    o_c = gated_delta_rule(qc, kc, vc, g, beta)
    o_c = rms_norm(o_c, dn_norm) * jax.nn.silu(z_c.astype(jnp.float32).reshape(B, S, DN_HEADS, DN_HEAD_DIM))
    mixed = jnp.concatenate([o_a.reshape(B, S, SWA_Q), o_b.reshape(B, S, MOBA_W),
                             o_c.reshape(B, S, DN_W).astype(h.dtype)], axis=-1)
    return mixed @ w_out


def conv_glu_ffn(h, w_up, conv_w, conv_b, w_down):
    u = causal_depthwise_conv(h @ w_up, conv_w) + conv_b
    gate, up = jnp.split(u, 2, axis=-1)
    return (jax.nn.gelu(gate, approximate=True) * up) @ w_down


def setup_inputs(seed: int = 0) -> dict:
    key = jax.random.key(seed)
    ks = jax.random.split(key, 16)
    f32 = jnp.float32

    def nrm(k, shape, scale):
        return jax.random.normal(k, shape, f32) * scale

    dt = jnp.exp(jax.random.uniform(ks[6], (DEPTH, DN_HEADS), f32)
                 * (math.log(0.1) - math.log(0.001)) + math.log(0.001))
    return {
        'x': nrm(ks[0], (BATCH, SEQ, D_MODEL), 1.0),
        'mix_pre_norm': 1.0 + nrm(ks[1], (DEPTH, D_MODEL), 0.05),
        'w_in': nrm(ks[2], (DEPTH, D_MODEL, IN_WIDTH), D_MODEL ** -0.5),
        'swa_sinks': nrm(ks[3], (DEPTH, SWA_HEADS), 0.5),
        'dn_conv_w': nrm(ks[4], (DEPTH, DN_CONV, 3 * DN_W), DN_CONV ** -0.5),
        'dn_a_log': jnp.log(jax.random.uniform(ks[5], (DEPTH, DN_HEADS), f32, 1.0, 16.0)),
        'dn_dt_bias': dt + jnp.log(-jnp.expm1(-dt)),
        'dn_norm': 1.0 + nrm(ks[7], (DEPTH, DN_HEAD_DIM), 0.05),
        'w_out': nrm(ks[8], (DEPTH, MIX_WIDTH, D_MODEL), MIX_WIDTH ** -0.5),
        'mix_post_norm': 1.0 + nrm(ks[9], (DEPTH, D_MODEL), 0.05),
        'ffn_pre_norm': 1.0 + nrm(ks[10], (DEPTH, D_MODEL), 0.05),
        'w_up': nrm(ks[11], (DEPTH, D_MODEL, 2 * D_FF), D_MODEL ** -0.5),
        'ffn_conv_w': nrm(ks[12], (DEPTH, FFN_CONV, 2 * D_FF), FFN_CONV ** -0.5),
        'ffn_conv_b': nrm(ks[13], (DEPTH, 2 * D_FF), 0.02),
        'w_down': nrm(ks[14], (DEPTH, D_FF, D_MODEL), D_FF ** -0.5),
        'ffn_post_norm': 1.0 + nrm(ks[15], (DEPTH, D_MODEL), 0.05),
    }


def reference(x, mix_pre_norm, w_in, swa_sinks, dn_conv_w, dn_a_log, dn_dt_bias, dn_norm, w_out,
              mix_post_norm, ffn_pre_norm, w_up, ffn_conv_w, ffn_conv_b, w_down, ffn_post_norm):
    slopes_swa, slopes_moba = alibi_slopes()
    for l in range(DEPTH):
        h = rms_norm(x, mix_pre_norm[l])
        mix = hybrid_token_mixer(h, w_in[l], swa_sinks[l], dn_conv_w[l], dn_a_log[l], dn_dt_bias[l],
                                 dn_norm[l], w_out[l], slopes_swa, slopes_moba)
        x = x + rms_norm(mix, mix_post_norm[l])
        h = rms_norm(x, ffn_pre_norm[l])
        x = x + rms_norm(conv_glu_ffn(h, w_up[l], ffn_conv_w[l], ffn_conv_b[l], w_down[l]), ffn_post_norm[l])
    return x
```

```cpp
#include <hip/hip_runtime.h>
#include <cstdio>
#include <cstdint>

constexpr int D_MODEL = 1024, BATCH = 4, SEQ = 8192, DEPTH = 2;
constexpr int IN_WIDTH = 3336, D_FF = 2816;
constexpr int COL_QA = 0, COL_KA = 256, COL_VA = 384, COL_QB = 512, COL_KB = 768, COL_VB = 1024, COL_QKVC = 1280, COL_Z = 2816, COL_BC = 3328, COL_AC = 3332;
constexpr float NORM_EPS = 1e-6f;

__global__ __launch_bounds__(256) void rmsnorm_rows(const float* __restrict__ x, const float* __restrict__ w, float* __restrict__ out, int rows) {
    const int wave = (blockIdx.x * 256 + threadIdx.x) >> 6, lane = threadIdx.x & 63;
    if (wave >= rows) return;
    const float4* xr = (const float4*)(x + (size_t)wave * D_MODEL);
    float4 v[4]; float s = 0.f;
#pragma unroll
    for (int j = 0; j < 4; ++j) { v[j] = xr[lane + 64 * j]; s += v[j].x * v[j].x + v[j].y * v[j].y + v[j].z * v[j].z + v[j].w * v[j].w; }
#pragma unroll
    for (int o = 1; o < 64; o <<= 1) s += __shfl_xor(s, o);
    const float r = rsqrtf(s * (1.f / D_MODEL) + NORM_EPS);
    float4* orow = (float4*)(out + (size_t)wave * D_MODEL);
    const float4* wr = (const float4*)w;
#pragma unroll
    for (int j = 0; j < 4; ++j) { const float4 ww = wr[lane + 64 * j]; float4 o; o.x = v[j].x * r * ww.x; o.y = v[j].y * r * ww.y; o.z = v[j].z * r * ww.z; o.w = v[j].w * r * ww.w; orow[lane + 64 * j] = o; }
}

__global__ __launch_bounds__(256) void add_norm_rows(const float* xin, const float* __restrict__ y, const float* __restrict__ w, float* xout,
                                                     const float* __restrict__ w2, float* __restrict__ hn, int rows) {
    const int wave = (blockIdx.x * 256 + threadIdx.x) >> 6, lane = threadIdx.x & 63;
    if (wave >= rows) return;
    const float4* yr = (const float4*)(y + (size_t)wave * D_MODEL);
    const float4* xr = (const float4*)(xin + (size_t)wave * D_MODEL);
    float4 v[4]; float s = 0.f;
#pragma unroll
    for (int j = 0; j < 4; ++j) { v[j] = yr[lane + 64 * j]; s += v[j].x * v[j].x + v[j].y * v[j].y + v[j].z * v[j].z + v[j].w * v[j].w; }
#pragma unroll
    for (int o = 1; o < 64; o <<= 1) s += __shfl_xor(s, o);
    const float r = rsqrtf(s * (1.f / D_MODEL) + NORM_EPS);
    float4* orow = (float4*)(xout + (size_t)wave * D_MODEL);
    const float4* wr = (const float4*)w;
    float s2 = 0.f;
#pragma unroll
    for (int j = 0; j < 4; ++j) { const float4 ww = wr[lane + 64 * j]; const float4 xx = xr[lane + 64 * j]; float4 o;
        o.x = xx.x + v[j].x * r * ww.x; o.y = xx.y + v[j].y * r * ww.y; o.z = xx.z + v[j].z * r * ww.z; o.w = xx.w + v[j].w * r * ww.w; orow[lane + 64 * j] = o; v[j] = o;
        s2 += o.x * o.x + o.y * o.y + o.z * o.z + o.w * o.w; }
    if (hn) {
#pragma unroll
        for (int o = 1; o < 64; o <<= 1) s2 += __shfl_xor(s2, o);
        const float r2 = rsqrtf(s2 * (1.f / D_MODEL) + NORM_EPS);
        float4* hrow = (float4*)(hn + (size_t)wave * D_MODEL);
        const float4* w2r = (const float4*)w2;
#pragma unroll
        for (int j = 0; j < 4; ++j) { const float4 ww = w2r[lane + 64 * j]; float4 o; o.x = v[j].x * r2 * ww.x; o.y = v[j].y * r2 * ww.y; o.z = v[j].z * r2 * ww.z; o.w = v[j].w * r2 * ww.w; hrow[lane + 64 * j] = o; }
    }
}

__global__ __launch_bounds__(256) void gemm_f32(const float* __restrict__ A, const float* __restrict__ B, float* __restrict__ C, int M, int N, int K, int lda, int ldb, int ldc) {
    __shared__ float As[16][132];
    __shared__ float Bs[16][132];
    const int tid = threadIdx.x, tx = tid & 15, ty = tid >> 4;
    const int bm = blockIdx.y * 128, bn = blockIdx.x * 128;
    float acc[8][8];
#pragma unroll
    for (int i = 0; i < 8; ++i)
#pragma unroll
        for (int j = 0; j < 8; ++j) acc[i][j] = 0.f;
    const int arow = tid >> 1, akoff = (tid & 1) * 8;
    const int brow = tid >> 4, bcol = (tid & 15) * 8;
    const float* Ap = A + (size_t)(bm + arow) * lda + akoff;
    const bool bok0 = (bn + bcol + 3) < N, bok1 = (bn + bcol + 7) < N;
    const float* Bp = B + (size_t)brow * ldb + bn + bcol;
    for (int k0 = 0; k0 < K; k0 += 16) {
        const float4 a0 = *(const float4*)(Ap + k0), a1 = *(const float4*)(Ap + k0 + 4);
        float4 b0 = make_float4(0.f, 0.f, 0.f, 0.f), b1 = b0;
        if (bok0) b0 = *(const float4*)(Bp + (size_t)k0 * ldb);
        if (bok1) b1 = *(const float4*)(Bp + (size_t)k0 * ldb + 4);
        __syncthreads();
        As[akoff + 0][arow] = a0.x; As[akoff + 1][arow] = a0.y; As[akoff + 2][arow] = a0.z; As[akoff + 3][arow] = a0.w;
        As[akoff + 4][arow] = a1.x; As[akoff + 5][arow] = a1.y; As[akoff + 6][arow] = a1.z; As[akoff + 7][arow] = a1.w;
        *(float4*)&Bs[brow][bcol] = b0; *(float4*)&Bs[brow][bcol + 4] = b1;
        __syncthreads();
#pragma unroll
        for (int k = 0; k < 16; ++k) {
            const float4 av0 = *(const float4*)&As[k][ty * 4], av1 = *(const float4*)&As[k][64 + ty * 4];
            const float4 bv0 = *(const float4*)&Bs[k][tx * 4], bv1 = *(const float4*)&Bs[k][64 + tx * 4];
            const float a[8] = {av0.x, av0.y, av0.z, av0.w, av1.x, av1.y, av1.z, av1.w};
            const float b[8] = {bv0.x, bv0.y, bv0.z, bv0.w, bv1.x, bv1.y, bv1.z, bv1.w};
#pragma unroll
            for (int i = 0; i < 8; ++i)
#pragma unroll
                for (int j = 0; j < 8; ++j) acc[i][j] = fmaf(a[i], b[j], acc[i][j]);
        }
    }
#pragma unroll
    for (int i = 0; i < 8; ++i) {
        const int r = bm + (i < 4 ? ty * 4 + i : 64 + ty * 4 + (i - 4));
#pragma unroll
        for (int jh = 0; jh < 2; ++jh) {
            const int c = bn + jh * 64 + tx * 4;
            if (c + 3 < N) *(float4*)(C + (size_t)r * ldc + c) = make_float4(acc[i][jh * 4 + 0], acc[i][jh * 4 + 1], acc[i][jh * 4 + 2], acc[i][jh * 4 + 3]);
        }
    }
}

__global__ __launch_bounds__(256) void swa_kernel(const float* __restrict__ proj, const float* __restrict__ sinks, float* __restrict__ mixed) {
    const int idx = blockIdx.x * 256 + threadIdx.x;
    const int t = idx % SEQ, hq = idx / SEQ, hkv = hq >> 1;
    const float slope = exp2f(-(float)(2 * hq + 1));
    const float* qp = proj + (size_t)t * IN_WIDTH + COL_QA + hq * 64;
    float q[64], o[64];
#pragma unroll
    for (int i = 0; i < 16; ++i) { const float4 v = ((const float4*)qp)[i]; q[4 * i] = v.x * 0.125f; q[4 * i + 1] = v.y * 0.125f; q[4 * i + 2] = v.z * 0.125f; q[4 * i + 3] = v.w * 0.125f; }
#pragma unroll
    for (int i = 0; i < 64; ++i) o[i] = 0.f;
    float mx = sinks[hq], l = 1.f;
    const int s0 = t - 127 < 0 ? 0 : t - 127;
    for (int s = s0; s <= t; ++s) {
        const float4* kp = (const float4*)(proj + (size_t)s * IN_WIDTH + COL_KA + hkv * 64);
        float d = 0.f;
#pragma unroll
        for (int i = 0; i < 16; ++i) { const float4 v = kp[i]; d = fmaf(q[4 * i], v.x, d); d = fmaf(q[4 * i + 1], v.y, d); d = fmaf(q[4 * i + 2], v.z, d); d = fmaf(q[4 * i + 3], v.w, d); }
        const float sc = d - slope * (float)(t - s);
        const float mn = fmaxf(mx, sc), f = __expf(mx - mn), p = __expf(sc - mn);
        mx = mn; l = l * f + p;
        const float4* vp = (const float4*)(proj + (size_t)s * IN_WIDTH + COL_VA + hkv * 64);
#pragma unroll
        for (int i = 0; i < 16; ++i) { const float4 v = vp[i]; o[4 * i] = fmaf(p, v.x, o[4 * i] * f); o[4 * i + 1] = fmaf(p, v.y, o[4 * i + 1] * f); o[4 * i + 2] = fmaf(p, v.z, o[4 * i + 2] * f); o[4 * i + 3] = fmaf(p, v.w, o[4 * i + 3] * f); }
    }
    const float rl = 1.f / l;
    float4* op = (float4*)(mixed + (size_t)t * D_MODEL + hq * 64);
#pragma unroll
    for (int i = 0; i < 16; ++i) op[i] = make_float4(o[4 * i] * rl, o[4 * i + 1] * rl, o[4 * i + 2] * rl, o[4 * i + 3] * rl);
}

__global__ __launch_bounds__(64) void moba_kmean(const float* __restrict__ proj, float* __restrict__ kmean) {
    const int h = blockIdx.x / 32, n = blockIdx.x % 32, d = threadIdx.x;
    float s = 0.f;
    for (int i = 0; i < 256; ++i) s += proj[(size_t)(n * 256 + i) * IN_WIDTH + COL_KB + h * 64 + d];
    kmean[(h * 32 + n) * 64 + d] = s * (1.f / 256.f);
}

__device__ __forceinline__ void moba_attend_block(const float* __restrict__ proj, int h, int t, int blk, int kend  , const float (&q)[64], float slope, float& mx, float& l, float (&o)[64]) {
    for (int i = 0; i < kend; ++i) {
        const int s = blk * 256 + i;
        const float4* kp = (const float4*)(proj + (size_t)s * IN_WIDTH + COL_KB + h * 64);
        float d = 0.f;
#pragma unroll
        for (int j = 0; j < 16; ++j) { const float4 v = kp[j]; d = fmaf(q[4 * j], v.x, d); d = fmaf(q[4 * j + 1], v.y, d); d = fmaf(q[4 * j + 2], v.z, d); d = fmaf(q[4 * j + 3], v.w, d); }
        const float sc = d * 0.125f - slope * (float)(t - s);
        const float mn = fmaxf(mx, sc), f = __expf(mx - mn), p = __expf(sc - mn);
        mx = mn; l = l * f + p;
        const float4* vp = (const float4*)(proj + (size_t)s * IN_WIDTH + COL_VB + h * 64);
#pragma unroll
        for (int j = 0; j < 16; ++j) { const float4 v = vp[j]; o[4 * j] = fmaf(p, v.x, o[4 * j] * f); o[4 * j + 1] = fmaf(p, v.y, o[4 * j + 1] * f); o[4 * j + 2] = fmaf(p, v.z, o[4 * j + 2] * f); o[4 * j + 3] = fmaf(p, v.w, o[4 * j + 3] * f); }
    }
}

__global__ __launch_bounds__(256) void moba_kernel(const float* __restrict__ proj, const float* __restrict__ kmean, float* __restrict__ mixed) {
    const int idx = blockIdx.x * 256 + threadIdx.x;
    const int t = idx % SEQ, h = idx / SEQ;
    const float slope = exp2f(-(float)(2 * h + 2));
    const float* qp = proj + (size_t)t * IN_WIDTH + COL_QB + h * 64;
    float q[64], o[64];
#pragma unroll
    for (int i = 0; i < 16; ++i) { const float4 v = ((const float4*)qp)[i]; q[4 * i] = v.x; q[4 * i + 1] = v.y; q[4 * i + 2] = v.z; q[4 * i + 3] = v.w; }
#pragma unroll
    for (int i = 0; i < 64; ++i) o[i] = 0.f;
    const int own = t >> 8;
    float g0 = -3e38f, g1 = -3e38f, g2 = -3e38f; int i0 = -1, i1 = -1, i2 = -1;
    for (int n = 0; n < own; ++n) {
        const float4* kp = (const float4*)(kmean + (h * 32 + n) * 64);
        float d = 0.f;
#pragma unroll
        for (int j = 0; j < 16; ++j) { const float4 v = kp[j]; d = fmaf(q[4 * j], v.x, d); d = fmaf(q[4 * j + 1], v.y, d); d = fmaf(q[4 * j + 2], v.z, d); d = fmaf(q[4 * j + 3], v.w, d); }
        if (d > g0) { g2 = g1; i2 = i1; g1 = g0; i1 = i0; g0 = d; i0 = n; }
        else if (d > g1) { g2 = g1; i2 = i1; g1 = d; i1 = n; }
        else if (d > g2) { g2 = d; i2 = n; }
    }
    float mx = -1e30f, l = 0.f;
    moba_attend_block(proj, h, t, own, (t & 255) + 1, q, slope, mx, l, o);
    if (i0 >= 0) moba_attend_block(proj, h, t, i0, 256, q, slope, mx, l, o);
    if (i1 >= 0) moba_attend_block(proj, h, t, i1, 256, q, slope, mx, l, o);
    if (i2 >= 0) moba_attend_block(proj, h, t, i2, 256, q, slope, mx, l, o);
    const float rl = 1.f / l;
    float4* op = (float4*)(mixed + (size_t)t * D_MODEL + 256 + h * 64);
#pragma unroll
    for (int i = 0; i < 16; ++i) op[i] = make_float4(o[4 * i] * rl, o[4 * i + 1] * rl, o[4 * i + 2] * rl, o[4 * i + 3] * rl);
}

__global__ __launch_bounds__(256) void dn_conv(const float* __restrict__ proj, const float* __restrict__ cw  , float* __restrict__ qkvc  ) {
    const int idx = blockIdx.x * 256 + threadIdx.x;
    const int t = idx / 384, c = (idx % 384) * 4;
    float4 acc = make_float4(0.f, 0.f, 0.f, 0.f);
#pragma unroll
    for (int i = 0; i < 4; ++i) {
        const int tt = t - 3 + i;
        if (tt >= 0) { const float4 x = *(const float4*)(proj + (size_t)tt * IN_WIDTH + COL_QKVC + c); const float4 w = *(const float4*)(cw + i * 1536 + c);
            acc.x = fmaf(w.x, x.x, acc.x); acc.y = fmaf(w.y, x.y, acc.y); acc.z = fmaf(w.z, x.z, acc.z); acc.w = fmaf(w.w, x.w, acc.w); }
    }
    acc.x = acc.x / (1.f + __expf(-acc.x)); acc.y = acc.y / (1.f + __expf(-acc.y)); acc.z = acc.z / (1.f + __expf(-acc.z)); acc.w = acc.w / (1.f + __expf(-acc.w));
    *(float4*)(qkvc + (size_t)t * 1536 + c) = acc;
}
__global__ __launch_bounds__(256) void dn_norm_gates(const float* __restrict__ proj, float* __restrict__ qkvc, const float* __restrict__ a_log, const float* __restrict__ dt_bias,
                                                     float* __restrict__ beta, float* __restrict__ g) {
    const int wave = (blockIdx.x * 256 + threadIdx.x) >> 6, lane = threadIdx.x & 63;
    const int t = wave >> 2, h = wave & 3;
#pragma unroll
    for (int which = 0; which < 2; ++which) {
        float2* p = (float2*)(qkvc + (size_t)t * 1536 + which * 512 + h * 128) + lane;
        float2 v = *p; float s = v.x * v.x + v.y * v.y;
#pragma unroll
        for (int o = 1; o < 64; o <<= 1) s += __shfl_xor(s, o);
        const float r = rsqrtf(s + NORM_EPS);
        v.x *= r; v.y *= r; *p = v;
    }
    if (lane == 0) {
        const float bc = proj[(size_t)t * IN_WIDTH + COL_BC + h], ac = proj[(size_t)t * IN_WIDTH + COL_AC + h] + dt_bias[h];
        beta[t * 4 + h] = 1.f / (1.f + expf(-bc));
        const float sp = ac > 20.f ? ac : log1pf(expf(ac));
        g[t * 4 + h] = -expf(a_log[h]) * sp;
    }
}
__global__ __launch_bounds__(256) void dn_scan(const float* __restrict__ qkvc, const float* __restrict__ beta, const float* __restrict__ g, float* __restrict__ oc  ) {
    const int h = blockIdx.x >> 3, cg = blockIdx.x & 7;
    const int dp = threadIdx.x & 15, el = threadIdx.x >> 4, e = cg * 16 + el;
    float s[8];
#pragma unroll
    for (int i = 0; i < 8; ++i) s[i] = 0.f;
    const float* qb = qkvc + h * 128 + dp * 8;
    const float* kb = qkvc + 512 + h * 128 + dp * 8;
    const float* vb = qkvc + 1024 + h * 128 + e;
    float4 k0 = *(const float4*)kb, k1 = *(const float4*)(kb + 4), q0 = *(const float4*)qb, q1 = *(const float4*)(qb + 4);
    float v = *vb, bt = beta[h], gt = g[h];
    const float qscale = 0.08838834764831845f;
    for (int t = 0; t < SEQ; ++t) {
        const float ck[8] = {k0.x, k0.y, k0.z, k0.w, k1.x, k1.y, k1.z, k1.w};
        const float cq[8] = {q0.x, q0.y, q0.z, q0.w, q1.x, q1.y, q1.z, q1.w};
        const float cv = v, cb = bt, eg = __expf(gt);
        if (t + 1 < SEQ) {
            const size_t off = (size_t)(t + 1) * 1536;
            k0 = *(const float4*)(kb + off); k1 = *(const float4*)(kb + off + 4); q0 = *(const float4*)(qb + off); q1 = *(const float4*)(qb + off + 4);
            v = vb[off]; bt = beta[(t + 1) * 4 + h]; gt = g[(t + 1) * 4 + h];
        }
        float ks = 0.f;
#pragma unroll
        for (int i = 0; i < 8; ++i) { s[i] *= eg; ks = fmaf(ck[i], s[i], ks); }
        ks += __shfl_xor(ks, 1); ks += __shfl_xor(ks, 2); ks += __shfl_xor(ks, 4); ks += __shfl_xor(ks, 8);
        const float c = cb * (cv - ks);
        float o = 0.f;
#pragma unroll
        for (int i = 0; i < 8; ++i) { s[i] = fmaf(ck[i], c, s[i]); o = fmaf(cq[i], s[i], o); }
        o += __shfl_xor(o, 1); o += __shfl_xor(o, 2); o += __shfl_xor(o, 4); o += __shfl_xor(o, 8);
        if (dp == 0) oc[(size_t)t * 512 + h * 128 + e] = o * qscale;
    }
}
__global__ __launch_bounds__(256) void dn_gate(const float* __restrict__ oc, const float* __restrict__ proj, const float* __restrict__ nw, float* __restrict__ mixed) {
    const int wave = (blockIdx.x * 256 + threadIdx.x) >> 6, lane = threadIdx.x & 63;
    const int t = wave >> 2, h = wave & 3;
    const float2 v = *((const float2*)(oc + (size_t)t * 512 + h * 128) + lane);
    float s = v.x * v.x + v.y * v.y;
#pragma unroll
    for (int o = 1; o < 64; o <<= 1) s += __shfl_xor(s, o);
    const float r = rsqrtf(s * (1.f / 128.f) + NORM_EPS);
    const float2 z = *((const float2*)(proj + (size_t)t * IN_WIDTH + COL_Z + h * 128) + lane);
    const float2 w = *((const float2*)nw + lane);
    float2 o; o.x = v.x * r * w.x * (z.x / (1.f + __expf(-z.x))); o.y = v.y * r * w.y * (z.y / (1.f + __expf(-z.y)));
    *((float2*)(mixed + (size_t)t * D_MODEL + 512 + h * 128) + lane) = o;
}

__device__ __forceinline__ float gelu_tanh(float x) { const float y = 0.7978845608028654f * (x + 0.044715f * x * x * x); return 0.5f * x * (1.f + tanhf(y)); }
__global__ __launch_bounds__(256) void conv_glu(const float* __restrict__ u, const float* __restrict__ cw  , const float* __restrict__ cb, float* __restrict__ act) {
    const int idx = blockIdx.x * 256 + threadIdx.x;
    const int t = idx / 704, c = (idx % 704) * 4;
    float4 ga = *(const float4*)(cb + c), ua = *(const float4*)(cb + D_FF + c);
#pragma unroll
    for (int i = 0; i < 3; ++i) {
        const int tt = t - 2 + i;
        if (tt >= 0) {
            const float4 xg = *(const float4*)(u + (size_t)tt * (2 * D_FF) + c), wg = *(const float4*)(cw + i * (2 * D_FF) + c);
            const float4 xu = *(const float4*)(u + (size_t)tt * (2 * D_FF) + D_FF + c), wu = *(const float4*)(cw + i * (2 * D_FF) + D_FF + c);
            ga.x = fmaf(wg.x, xg.x, ga.x); ga.y = fmaf(wg.y, xg.y, ga.y); ga.z = fmaf(wg.z, xg.z, ga.z); ga.w = fmaf(wg.w, xg.w, ga.w);
            ua.x = fmaf(wu.x, xu.x, ua.x); ua.y = fmaf(wu.y, xu.y, ua.y); ua.z = fmaf(wu.z, xu.z, ua.z); ua.w = fmaf(wu.w, xu.w, ua.w);
        }
    }
    *(float4*)(act + (size_t)t * D_FF + c) = make_float4(gelu_tanh(ga.x) * ua.x, gelu_tanh(ga.y) * ua.y, gelu_tanh(ga.z) * ua.z, gelu_tanh(ga.w) * ua.w);
}

static void gemm(const float* A, const float* B, float* C, int M, int N, int K, int lda, int ldb, int ldc, hipStream_t st) {
    dim3 grid((N + 127) / 128, M / 128);
    hipLaunchKernelGGL(gemm_f32, grid, dim3(256), 0, st, A, B, C, M, N, K, lda, ldb, ldc);
}

extern "C" void kernel_launch(void* const* d_in, const int* in_sizes, int n_in, void* d_out, int out_size, void* d_ws, size_t ws_size, hipStream_t stream) {
    const float* x_in = (const float*)d_in[0];
    const float* mix_pre = (const float*)d_in[1];
    const float* w_in = (const float*)d_in[2];
    const float* sinks = (const float*)d_in[3];
    const float* dn_cw = (const float*)d_in[4];
    const float* a_log = (const float*)d_in[5];
    const float* dt_bias = (const float*)d_in[6];
    const float* dn_nw = (const float*)d_in[7];
    const float* w_out = (const float*)d_in[8];
    const float* mix_post = (const float*)d_in[9];
    const float* ffn_pre = (const float*)d_in[10];
    const float* w_up = (const float*)d_in[11];
    const float* f_cw = (const float*)d_in[12];
    const float* f_cb = (const float*)d_in[13];
    const float* w_down = (const float*)d_in[14];
    const float* ffn_post = (const float*)d_in[15];
    float* out = (float*)d_out;
    float* ws = (float*)d_ws;
    size_t off = 0;
    float* hn = ws + off; off += (size_t)SEQ * D_MODEL;
    float* R1 = ws + off; off += (size_t)SEQ * 2 * D_FF;
    float* proj = R1; float* qkvc = R1 + (size_t)SEQ * IN_WIDTH; float* ubuf = R1;
    float* oc = ws + off; off += (size_t)SEQ * 512;
    float* mixed = ws + off; off += (size_t)SEQ * D_MODEL;
    float* y = ws + off; off += (size_t)SEQ * D_MODEL;
    float* act = ws + off; off += (size_t)SEQ * D_FF;
    float* kmean = ws + off; off += 4 * 32 * 64;
    float* beta = ws + off; off += SEQ * 4;
    float* gbuf = ws + off; off += SEQ * 4;
    if (off * 4 > ws_size) { fprintf(stderr, "workspace too small: need %zu have %zu\n", off * 4, ws_size); return; }

    for (int l = 0; l < DEPTH; ++l) {
        for (int b = 0; b < BATCH; ++b) {
            const float* xb = (l == 0 ? x_in : out) + (size_t)b * SEQ * D_MODEL;
            float* ob = out + (size_t)b * SEQ * D_MODEL;
            hipLaunchKernelGGL(rmsnorm_rows, dim3(SEQ / 4), dim3(256), 0, stream, xb, mix_pre + l * D_MODEL, hn, SEQ);
            gemm(hn, w_in + (size_t)l * D_MODEL * IN_WIDTH, proj, SEQ, IN_WIDTH, D_MODEL, D_MODEL, IN_WIDTH, IN_WIDTH, stream);
            hipLaunchKernelGGL(swa_kernel, dim3(SEQ * 4 / 256), dim3(256), 0, stream, proj, sinks + l * 4, mixed);
            hipLaunchKernelGGL(moba_kmean, dim3(4 * 32), dim3(64), 0, stream, proj, kmean);
            hipLaunchKernelGGL(moba_kernel, dim3(SEQ * 4 / 256), dim3(256), 0, stream, proj, kmean, mixed);
            hipLaunchKernelGGL(dn_conv, dim3(SEQ * 384 / 256), dim3(256), 0, stream, proj, dn_cw + (size_t)l * 4 * 1536, qkvc);
            hipLaunchKernelGGL(dn_norm_gates, dim3(SEQ * 4 / 4), dim3(256), 0, stream, proj, qkvc, a_log + l * 4, dt_bias + l * 4, beta, gbuf);
            hipLaunchKernelGGL(dn_scan, dim3(32), dim3(256), 0, stream, qkvc, beta, gbuf, oc);
            hipLaunchKernelGGL(dn_gate, dim3(SEQ * 4 / 4), dim3(256), 0, stream, oc, proj, dn_nw + l * 128, mixed);
            gemm(mixed, w_out + (size_t)l * D_MODEL * D_MODEL, y, SEQ, D_MODEL, D_MODEL, D_MODEL, D_MODEL, D_MODEL, stream);
            hipLaunchKernelGGL(add_norm_rows, dim3(SEQ / 4), dim3(256), 0, stream, xb, y, mix_post + l * D_MODEL, ob, ffn_pre + l * D_MODEL, hn, SEQ);
            gemm(hn, w_up + (size_t)l * D_MODEL * 2 * D_FF, ubuf, SEQ, 2 * D_FF, D_MODEL, D_MODEL, 2 * D_FF, 2 * D_FF, stream);
            hipLaunchKernelGGL(conv_glu, dim3(SEQ * 704 / 256), dim3(256), 0, stream, ubuf, f_cw + (size_t)l * 3 * 2 * D_FF, f_cb + (size_t)l * 2 * D_FF, act);
            gemm(act, w_down + (size_t)l * D_FF * D_MODEL, y, SEQ, D_MODEL, D_FF, D_FF, D_MODEL, D_MODEL, stream);
            hipLaunchKernelGGL(add_norm_rows, dim3(SEQ / 4), dim3(256), 0, stream, (const float*)ob, y, ffn_post + l * D_MODEL, ob, (const float*)nullptr, (float*)nullptr, SEQ);
        }
    }
}
```

```cpp
#include <hip/hip_runtime.h>
#include <cstdio>
#include <cstdint>

constexpr int D_MODEL = 1024, BATCH = 4, SEQ = 8192, DEPTH = 2, T_TOK = BATCH * SEQ;
constexpr int IN_WIDTH = 3336, IN_PAD = 3584, PROJ_W = 3328, D_FF = 2816;
constexpr int COL_QA = 0, COL_KA = 256, COL_VA = 384, COL_QB = 512, COL_KB = 768, COL_VB = 1024, COL_QKVC = 1280, COL_Z = 2816;
constexpr float NORM_EPS = 1e-6f;
constexpr int NWAVES = 8, NTHREADS = 512;

constexpr size_t MiB = 1u << 20;
constexpr size_t WS_CTL = 0, CTL_ZERO_BYTES = 1 * MiB;
constexpr size_t WS_GATES = 1 * MiB;
constexpr size_t WS_SEL = 2 * MiB;
constexpr size_t WS_BG = 3 * MiB;
constexpr size_t WS_W = 4 * MiB, W_LAYER = 26 * MiB;
constexpr size_t W_IN = 0, W_OUT = 7 * MiB, W_UP = 9 * MiB, W_DOWN = 20 * MiB;
constexpr size_t WS_XN = 56 * MiB;
constexpr size_t WS_DNI = 56 * MiB;
constexpr size_t WS_PROJ = 200 * MiB;
constexpr size_t WS_ACT = 200 * MiB;
constexpr size_t WS_MIXED = 408 * MiB;
constexpr size_t WS_SPARE = 472 * MiB;
constexpr size_t WS_END = 512 * MiB;
constexpr size_t WS_QKVC = 56 * MiB;
constexpr size_t WS_OC = WS_SPARE;
constexpr size_t WS_Y1 = WS_PROJ;
constexpr size_t WS_Y2 = 376 * MiB;
constexpr size_t WS_UB = 408 * MiB;
constexpr int CW_BAR = 4096;
constexpr int CW_KMEAN = 131072;
static_assert((CW_KMEAN + 2 * 32768) * 4 <= (int)CTL_ZERO_BYTES, "ctl");

constexpr int RING_OFF = 0, RING_BYTES = 131072;
constexpr int LDSCTL_OFF = RING_BYTES, MISC_OFF = LDSCTL_OFF + 320;
constexpr int LDS_BYTES = 147456;

typedef unsigned short f16_t;
typedef _Float16 h8 __attribute__((ext_vector_type(8)));
typedef _Float16 h4 __attribute__((ext_vector_type(4)));
typedef _Float16 h2 __attribute__((ext_vector_type(2)));
__device__ __forceinline__ unsigned pk_f16(float lo, float hi) { h2 v = {(_Float16)lo, (_Float16)hi}; return __builtin_bit_cast(unsigned, v); }
__device__ __forceinline__ float h2f(f16_t b) { return (float)__builtin_bit_cast(_Float16, b); }
__device__ __forceinline__ f16_t f2h(float f) { return __builtin_bit_cast(f16_t, (_Float16)f); }

namespace pg8 {
#define PG8_LAS __attribute__((address_space(3)))
typedef unsigned short bf16_t;
typedef _Float16 bf16x8 __attribute__((ext_vector_type(8)));
typedef float f32x4 __attribute__((ext_vector_type(4)));
typedef unsigned u32x4 __attribute__((ext_vector_type(4)));
constexpr int BM = 256, BK = 64, HALF = 128, HTB = HALF * BK * 2  , STAGE_BYTES = 8 * HTB, NXCD = 8, WGM = 8;

__host__ __device__ __forceinline__ int lds_byte(int r, int c) { const int st = (r >> 4) * 2 + (c >> 5), rr = r & 15, cc = c & 31, ob = rr * 64 + cc * 2; return st * 1024 + (ob ^ (((ob >> 9) & 1) << 5)); }
__host__ __device__ __forceinline__ void stage_rc(int b, int& R, int& C) { const int st = b / 1024, sb = b % 1024, swz = sb ^ (((sb >> 9) & 1) << 5); R = (st >> 1) * 16 + swz / 64; C = (st & 1) * 32 + (swz % 64) / 2; }
__host__ __device__ __forceinline__ int perm32(int rho) { const int n = rho >> 4, i = rho & 15; return 8 * (i >> 2) + 4 * n + (i & 3); }

struct Unit { int pm, pn; };
struct Gemm { const bf16_t* A; const bf16_t* Bt; int M, N, K; };

struct StaticOrder {
    int nM, nN, nwg, G, c;
    __host__ __device__ void init(int M, int N, int G_, int c_) { nM = M / BM; nN = N / BM; nwg = nM * nN; G = G_; c = c_; }
    __host__ __device__ bool next(int i, Unit& u) const {
        const long L = (long)i * G + c; if (L >= nwg) return false;
        int wgid = (int)L; { const int q = nwg / NXCD, r = nwg % NXCD, xcd = wgid % NXCD, off = wgid / NXCD; wgid = (xcd < r ? xcd * (q + 1) : r * (q + 1) + (xcd - r) * q) + off; }
        const int nig = WGM * nN, gid = wgid / nig, fm = gid * WGM, gsz = (nM - fm) < WGM ? (nM - fm) : WGM;
        u.pm = fm + ((wgid % nig) % gsz); u.pn = (wgid % nig) / gsz; return true;
    }
    __device__ __forceinline__ void a_ready(const Unit&) const {}
    __device__ __forceinline__ void done(const Unit&) const {}
};

struct EpiF32 {
    static constexpr bool PERM = false, AFTER_DRAIN = false;
    float* C; int ldc;
    __device__ __forceinline__ void operator()(const f32x4 (&acc)[2][2][4][2], const Unit& u, int wr, int wc, int fr, int fq) const {
        const int row0 = u.pm * BM + wr * 64 + fr, col0 = u.pn * BM + wc * 32 + 4 * fq;
#pragma unroll
        for (int ai = 0; ai < 2; ++ai)
#pragma unroll
            for (int m = 0; m < 4; ++m) { float* rowp = C + (size_t)(row0 + ai * HALF + m * 16) * ldc + col0;
#pragma unroll
                for (int bj = 0; bj < 2; ++bj)
#pragma unroll
                    for (int n = 0; n < 2; ++n) *(f32x4*)(rowp + bj * HALF + n * 16) = acc[ai][bj][m][n]; }
    }
};
struct EpiF16 {
    static constexpr bool PERM = true, AFTER_DRAIN = false;
    bf16_t* O; int ldc;
    __device__ __forceinline__ void operator()(const f32x4 (&acc)[2][2][4][2], const Unit& u, int wr, int wc, int fr, int fq) const {
        const int row0 = u.pm * BM + wr * 64 + fr, col0 = u.pn * BM + wc * 32 + 8 * fq;
#pragma unroll
        for (int ai = 0; ai < 2; ++ai)
#pragma unroll
            for (int m = 0; m < 4; ++m) { bf16_t* rowp = O + (size_t)(row0 + ai * HALF + m * 16) * ldc + col0;
#pragma unroll
                for (int bj = 0; bj < 2; ++bj) { const f32x4 v0 = acc[ai][bj][m][0], v1 = acc[ai][bj][m][1];
                    u32x4 w; w.x = pk_f16(v0[0], v0[1]); w.y = pk_f16(v0[2], v0[3]); w.z = pk_f16(v1[0], v1[1]); w.w = pk_f16(v1[2], v1[3]);
                    *(u32x4*)(rowp + bj * HALF) = w; } }
    }
};
struct EpiProj {
    static constexpr bool PERM = true, AFTER_DRAIN = false;
    bf16_t* P; float* gates; float* kmean;
    __device__ __forceinline__ void operator()(const f32x4 (&acc)[2][2][4][2], const Unit& u, int wr, int wc, int fr, int fq) const {
        const int row0 = u.pm * BM + wr * 64 + fr;
        if (u.pn < 13) {
            const int col0 = u.pn * BM + wc * 32 + 8 * fq;
#pragma unroll
            for (int ai = 0; ai < 2; ++ai)
#pragma unroll
                for (int m = 0; m < 4; ++m) { bf16_t* rowp = P + (size_t)(row0 + ai * HALF + m * 16) * PROJ_W + col0;
#pragma unroll
                    for (int bj = 0; bj < 2; ++bj) { const f32x4 v0 = acc[ai][bj][m][0], v1 = acc[ai][bj][m][1];
                        u32x4 w; w.x = pk_f16(v0[0], v0[1]); w.y = pk_f16(v0[2], v0[3]); w.z = pk_f16(v1[0], v1[1]); w.w = pk_f16(v1[2], v1[3]);
                        *(u32x4*)(rowp + bj * HALF) = w; } }
            if (u.pn == 3) {
                const int b = u.pm >> 5, nb = u.pm & 31;
#pragma unroll
                for (int bj = 0; bj < 2; ++bj)
#pragma unroll
                    for (int n = 0; n < 2; ++n) {
                        f32x4 s = {0.f, 0.f, 0.f, 0.f};
#pragma unroll
                        for (int ai = 0; ai < 2; ++ai)
#pragma unroll
                            for (int m = 0; m < 4; ++m) s += acc[ai][bj][m][n];
#pragma unroll
                        for (int j = 0; j < 4; ++j) { float v = s[j]; v += __shfl_xor(v, 1); v += __shfl_xor(v, 2); v += __shfl_xor(v, 4); v += __shfl_xor(v, 8); s[j] = v; }
                        if (fr == 0) { const int c = 128 * bj + 32 * wc + 8 * fq + 4 * n, h = c >> 6, d = c & 63; float* kp = kmean + (size_t)((b * 4 + h) * 32 + nb) * 64 + d;
#pragma unroll
                            for (int j = 0; j < 4; ++j) atomicAdd(kp + j, s[j] * (1.0f / 256.0f)); }
                    }
            }
        } else if (wc == 0 && fq == 0) {
#pragma unroll
            for (int ai = 0; ai < 2; ++ai)
#pragma unroll
                for (int m = 0; m < 4; ++m) { float* gp = gates + (size_t)(row0 + ai * HALF + m * 16) * 8;
                    *(f32x4*)gp = acc[ai][0][m][0]; *(f32x4*)(gp + 4) = acc[ai][0][m][1]; }
        }
    }
};

template <class Epi, class Sched, bool ALIGN_EPI = false, bool SP2 = false>
__device__ __forceinline__ void gemm_phase(PG8_LAS unsigned char* lds, const Gemm g, const Sched& S, const Epi& E) {
    int tid_ = threadIdx.x; asm volatile("" : "+v"(tid_));
    const int tid = tid_, wid = __builtin_amdgcn_readfirstlane(tid >> 6), lane = tid & 63, wr = wid >> 2, wc = wid & 3, fr = lane & 15, fq = lane >> 4;
    const int K = g.K, nt = K / BK;
    unsigned voffA[2], voffB[2];
#pragma unroll
    for (int i = 0; i < 2; ++i) { int R, C; stage_rc(tid * 16 + i * 8192, R, C); const int Rb = Epi::PERM ? ((R & ~31) + perm32(R & 31)) : R;
        voffA[i] = (unsigned)(R * K + C) * 2u; voffB[i] = (unsigned)(Rb * K + C) * 2u; }
    const size_t kstep = (size_t)(BK * 2);
    const size_t hstep = (size_t)HALF * K * 2;
    const size_t tstep = 2 * hstep;
    const unsigned ldsw = (unsigned)wid * 1024u;
    const int aoff = lds_byte(wr * 64 + fr, fq * 8), boff = lds_byte(wc * 32 + fr, fq * 8);
#define PG8_SA(b, h) (((b) * 2 + (h)) * HTB)
#define PG8_SB(b, h) ((4 + (b) * 2 + (h)) * HTB)
#define PG8_STAGE(bufoff, gbase, voff) do { _Pragma("unroll") for (int _i = 0; _i < 2; ++_i) \
        __builtin_amdgcn_global_load_lds((const unsigned*)((const char*)(gbase) + (voff)[_i]), (PG8_LAS unsigned*)(lds + (bufoff) + ldsw + _i * 8192), 16, 0, 0); } while (0)
#define PG8_LDA(dst, b, h) do { _Pragma("unroll") for (int m = 0; m < 4; ++m) _Pragma("unroll") for (int k = 0; k < 2; ++k) dst[m][k] = *(const PG8_LAS bf16x8*)(lds + PG8_SA(b, h) + aoff + m * 2048 + k * 1024); } while (0)
#define PG8_LDB(dst, b, h) do { _Pragma("unroll") for (int n = 0; n < 2; ++n) _Pragma("unroll") for (int k = 0; k < 2; ++k) dst[n][k] = *(const PG8_LAS bf16x8*)(lds + PG8_SB(b, h) + boff + n * 2048 + k * 1024); } while (0)
#define PG8_MMA(ai, bj, At, Bt) do { __builtin_amdgcn_s_setprio(1); _Pragma("unroll") for (int m = 0; m < 4; ++m) _Pragma("unroll") for (int n = 0; n < 2; ++n) _Pragma("unroll") for (int k = 0; k < 2; ++k) \
        acc[ai][bj][m][n] = __builtin_amdgcn_mfma_f32_16x16x32_f16(Bt[n][k], At[m][k], acc[ai][bj][m][n], 0, 0, 0); __builtin_amdgcn_s_setprio(0); } while (0)
#define PG8_WAIT_V(n) asm volatile("s_waitcnt vmcnt(" #n ")" ::: "memory")
#define PG8_WAIT_L(n) asm volatile("s_waitcnt lgkmcnt(" #n ")" ::: "memory")
#define PG8_BAR __builtin_amdgcn_s_barrier()
#define PG8_SCHED __builtin_amdgcn_sched_barrier(0)
    Unit cur, nxt; int ui = 0;
    if (!S.next(0, cur)) return;
    f32x4 acc[2][2][4][2];
#pragma unroll
    for (int a = 0; a < 2; ++a)
#pragma unroll
        for (int b = 0; b < 2; ++b)
#pragma unroll
            for (int m = 0; m < 4; ++m)
#pragma unroll
                for (int n = 0; n < 2; ++n) acc[a][b][m][n] = (f32x4){0.f, 0.f, 0.f, 0.f};
    bf16x8 At[4][2], B0[2][2], B1[2][2];
    const char* cA = (const char*)g.A + (size_t)cur.pm * tstep; const char* cB = (const char*)g.Bt + (size_t)cur.pn * tstep;
    S.a_ready(cur);
    if constexpr (SP2) {
        PG8_STAGE(PG8_SB(0, 0), cB, voffB); PG8_STAGE(PG8_SB(0, 1), cB + hstep, voffB); PG8_STAGE(PG8_SA(0, 0), cA, voffA); PG8_STAGE(PG8_SA(0, 1), cA + hstep, voffA);
        if (wr == 1) PG8_BAR;
        PG8_WAIT_V(2); PG8_BAR;
        PG8_STAGE(PG8_SB(1, 0), cB + kstep, voffB); PG8_STAGE(PG8_SA(1, 0), cA + kstep, voffA); PG8_STAGE(PG8_SB(1, 1), cB + hstep + kstep, voffB);
        PG8_WAIT_V(6); PG8_BAR;
    } else {
        PG8_STAGE(PG8_SB(0, 0), cB, voffB); PG8_STAGE(PG8_SA(0, 0), cA, voffA); PG8_STAGE(PG8_SB(0, 1), cB + hstep, voffB); PG8_STAGE(PG8_SA(0, 1), cA + hstep, voffA);
        if (wr == 1) PG8_BAR;
        PG8_WAIT_V(4); PG8_BAR;
        PG8_STAGE(PG8_SB(1, 0), cB + kstep, voffB); PG8_STAGE(PG8_SA(1, 0), cA + kstep, voffA); PG8_STAGE(PG8_SB(1, 1), cB + hstep + kstep, voffB);
        PG8_WAIT_V(6); PG8_BAR;
    }
    for (;;) {
        const bool has_next = S.next(ui + 1, nxt);
        const char* nA = has_next ? (const char*)g.A + (size_t)nxt.pm * tstep : cA; const char* nB = has_next ? (const char*)g.Bt + (size_t)nxt.pn * tstep : cB;
        for (int t = 0; t < nt; t += 2) {
            const bool last = (t == nt - 2);
            const char* a1 = cA + (size_t)(t + 1) * kstep;
            const char* a2 = last ? nA : cA + (size_t)(t + 2) * kstep; const char* b2 = last ? nB : cB + (size_t)(t + 2) * kstep;
            const char* a3 = a2 + kstep; const char* b3 = b2 + kstep;
            if (last && has_next) S.a_ready(nxt);
            if constexpr (SP2) {
            PG8_LDB(B0, 0, 0); PG8_LDB(B1, 0, 1); PG8_SCHED; PG8_LDA(At, 0, 0); PG8_STAGE(PG8_SA(1, 1), a1 + hstep, voffA);
            PG8_WAIT_V(8); PG8_WAIT_L(0); PG8_BAR; PG8_MMA(0, 0, At, B0); PG8_MMA(0, 1, At, B1); PG8_BAR; PG8_SCHED;
            PG8_LDA(At, 0, 1); PG8_STAGE(PG8_SB(0, 0), b2, voffB); PG8_STAGE(PG8_SB(0, 1), b2 + hstep, voffB); PG8_STAGE(PG8_SA(0, 0), a2, voffA);
            PG8_WAIT_V(8); PG8_WAIT_L(0); PG8_BAR; PG8_MMA(1, 0, At, B0); PG8_MMA(1, 1, At, B1); PG8_BAR; PG8_SCHED;
            PG8_LDB(B0, 1, 0); PG8_LDB(B1, 1, 1); PG8_SCHED; PG8_LDA(At, 1, 0); PG8_STAGE(PG8_SA(0, 1), a2 + hstep, voffA);
            PG8_WAIT_V(8); PG8_WAIT_L(0); PG8_BAR; PG8_MMA(0, 0, At, B0); PG8_MMA(0, 1, At, B1); PG8_BAR; PG8_SCHED;
            PG8_LDA(At, 1, 1); PG8_STAGE(PG8_SB(1, 0), b3, voffB); PG8_STAGE(PG8_SB(1, 1), b3 + hstep, voffB); PG8_STAGE(PG8_SA(1, 0), a3, voffA);
            PG8_WAIT_V(8); PG8_WAIT_L(0); PG8_BAR; PG8_MMA(1, 0, At, B0); PG8_MMA(1, 1, At, B1); PG8_BAR; PG8_SCHED;
            } else {
            PG8_LDB(B0, 0, 0); PG8_SCHED; PG8_LDA(At, 0, 0); PG8_STAGE(PG8_SA(1, 1), a1 + hstep, voffA);
            PG8_WAIT_L(8); PG8_BAR; PG8_WAIT_L(0); PG8_MMA(0, 0, At, B0); PG8_BAR; PG8_SCHED;
            PG8_LDB(B1, 0, 1); PG8_STAGE(PG8_SB(0, 0), b2, voffB);
            PG8_BAR; PG8_WAIT_L(0); PG8_MMA(0, 1, At, B1); PG8_BAR;
            PG8_LDA(At, 0, 1); PG8_STAGE(PG8_SA(0, 0), a2, voffA);
            PG8_BAR; PG8_WAIT_L(0); PG8_MMA(1, 0, At, B0); PG8_BAR; PG8_SCHED;
            PG8_STAGE(PG8_SB(0, 1), b2 + hstep, voffB);
            PG8_WAIT_V(6); PG8_BAR; PG8_MMA(1, 1, At, B1); PG8_BAR;
            PG8_LDB(B0, 1, 0); PG8_SCHED; PG8_LDA(At, 1, 0); PG8_STAGE(PG8_SA(0, 1), a2 + hstep, voffA);
            PG8_WAIT_L(8); PG8_BAR; PG8_WAIT_L(0); PG8_MMA(0, 0, At, B0); PG8_BAR; PG8_SCHED;
            PG8_LDB(B1, 1, 1); PG8_STAGE(PG8_SB(1, 0), b3, voffB);
            PG8_BAR; PG8_WAIT_L(0); PG8_MMA(0, 1, At, B1); PG8_BAR;
            PG8_LDA(At, 1, 1); PG8_STAGE(PG8_SA(1, 0), a3, voffA);
            PG8_BAR; PG8_WAIT_L(0); PG8_MMA(1, 0, At, B0); PG8_BAR; PG8_SCHED;
            PG8_STAGE(PG8_SB(1, 1), b3 + hstep, voffB);
            PG8_WAIT_V(6); PG8_BAR; PG8_MMA(1, 1, At, B1); PG8_BAR;
            }
        }
        if constexpr (ALIGN_EPI) { if (wr == 0) PG8_BAR; }
        if constexpr (!Epi::AFTER_DRAIN) { E(acc, cur, wr, wc, fr, fq); S.done(cur); }
        if (!has_next) break;
#pragma unroll
        for (int a = 0; a < 2; ++a)
#pragma unroll
            for (int b = 0; b < 2; ++b)
#pragma unroll
                for (int m = 0; m < 4; ++m)
#pragma unroll
                    for (int n = 0; n < 2; ++n) acc[a][b][m][n] = (f32x4){0.f, 0.f, 0.f, 0.f};
        cur = nxt; cA = nA; cB = nB; ++ui;
        if constexpr (ALIGN_EPI) { if (wr == 1) PG8_BAR; }
    }
    PG8_WAIT_V(0);
    if constexpr (!ALIGN_EPI) { if (wr == 0) PG8_BAR; }
    PG8_BAR;
    if constexpr (Epi::AFTER_DRAIN) { E.fused(acc, cur, wr, wc, fr, fq, lds, wid, lane); S.done(cur); }
#undef PG8_SA
#undef PG8_SB
#undef PG8_STAGE
#undef PG8_LDA
#undef PG8_LDB
#undef PG8_MMA
#undef PG8_WAIT_V
#undef PG8_WAIT_L
#undef PG8_BAR
#undef PG8_SCHED
}
}
#define GAS __attribute__((address_space(1)))
#define LAS __attribute__((address_space(3)))
typedef GAS unsigned gu32;
typedef GAS unsigned long long gu64;
#define RLX_AGENT __ATOMIC_RELAXED, __HIP_MEMORY_SCOPE_AGENT
#define LDS_WAIT() asm volatile("s_waitcnt lgkmcnt(0)" ::: "memory")
#define VM_WAIT() asm volatile("s_waitcnt vmcnt(0)" ::: "memory")
#define XB_TMO      128
#define XB_XCNT(j)  (256  + 64 * (j))
#define XB_XSUB(j)  (1280 + 64 * (j))
#define XB_XGEN(j)  (2304 + 64 * (j))
#define XB_TOP      3328
#define XB_TOPGEN   3392
#define XCD_BAR_WORDS 3456
#define XB_SPIN_CAP (1u << 18)

__device__ __forceinline__ unsigned xb_ld(unsigned* p)              { return __hip_atomic_load(p, __ATOMIC_RELAXED, __HIP_MEMORY_SCOPE_AGENT); }
__device__ __forceinline__ unsigned xb_add(unsigned* p, unsigned v) { return __hip_atomic_fetch_add(p, v, __ATOMIC_RELAXED, __HIP_MEMORY_SCOPE_AGENT); }
__device__ __forceinline__ unsigned xb_xcc_id() { return (unsigned)__builtin_amdgcn_s_getreg((3 << 11) | 20) & 0xFu; }
#define XB_SPIN(cond, bar) do { unsigned _sp = 0; while (cond) { __builtin_amdgcn_s_sleep(1); \
    if ((++_sp & 255u) == 0u) { if (xb_ld(&(bar)[XB_TMO])) break; if (_sp > XB_SPIN_CAP) { atomicAdd(&(bar)[XB_TMO], 1u); break; } } } } while (0)

struct XcdBarrier {
    unsigned* bar; unsigned x;
    volatile LAS unsigned* st;
};

__device__ __forceinline__ XcdBarrier xcd_barrier_post(unsigned* bar, volatile LAS unsigned* st) {
    XcdBarrier b; b.bar = bar; b.x = xb_xcc_id(); b.st = st;
    if (threadIdx.x == 0) (void)xb_add(&bar[XB_XCNT(b.x)], 1u);
    return b;
}
__device__ __forceinline__ void xcd_barrier_complete(unsigned* bar, unsigned x, unsigned& nloc, unsigned& nx) {
    const unsigned G = gridDim.x * gridDim.y * gridDim.z;
    unsigned sum, cnt, mine, sp = 0u;
    for (;;) {
        sum = 0u; cnt = 0u; mine = 0u;
#pragma unroll
        for (unsigned j = 0; j < 16; ++j) { const unsigned c = xb_ld(&bar[XB_XCNT(j)]); sum += c; cnt += (c > 0u) ? 1u : 0u; mine = (j == x) ? c : mine; }
        if (sum == G) break;
        __builtin_amdgcn_s_sleep(1);
        if ((++sp & 255u) == 0u) { if (xb_ld(&bar[XB_TMO])) break; if (sp > XB_SPIN_CAP) { atomicAdd(&bar[XB_TMO], 1u); break; } }
    }
    nloc = mine > 0u ? mine : 1u; nx = cnt > 0u ? cnt : 1u;
}

__device__ __forceinline__ void xcd_barrier(const XcdBarrier& b) {
    asm volatile("s_waitcnt vmcnt(0)" ::: "memory");
    __syncthreads();
    if (threadIdx.x == 0) {
        unsigned* bar = b.bar;
        __builtin_amdgcn_s_waitcnt(0);
        unsigned nloc = b.st[0], nx = b.st[1];
        if (nloc == 0u) { xcd_barrier_complete(bar, b.x, nloc, nx); b.st[0] = nloc; b.st[1] = nx; }
        const unsigned old = xb_add(&bar[XB_XSUB(b.x)], 1u);
        const unsigned gen = old / nloc;
        if (old + 1u == (gen + 1u) * nloc) {
            __builtin_amdgcn_fence(__ATOMIC_RELEASE, "agent");
            asm volatile("s_waitcnt vmcnt(0)" ::: "memory");
            const unsigned og = xb_add(&bar[XB_TOP], 1u);
            const unsigned tg = og / nx;
            if (og + 1u == (tg + 1u) * nx) xb_add(&bar[XB_TOPGEN], 1u);
            else XB_SPIN(xb_ld(&bar[XB_TOPGEN]) == tg, bar);
            __builtin_amdgcn_fence(__ATOMIC_ACQUIRE, "agent");
            xb_add(&bar[XB_XGEN(b.x)], 1u);
            asm volatile("s_waitcnt vmcnt(0)" ::: "memory");
        } else {
            XB_SPIN(xb_ld(&bar[XB_XGEN(b.x)]) == gen, bar);
            __builtin_amdgcn_fence(__ATOMIC_ACQUIRE, "agent");
            asm volatile("s_waitcnt vmcnt(0)" ::: "memory");
        }
    }
    __syncthreads();
}

struct Args { const float* in[16]; float* out; unsigned char* ws; };

struct Frame {
    LAS unsigned char* lds;
    int tid, lane, wave, G, bid;
};

__device__ __forceinline__ float wave_sum(float v) {
#pragma unroll
    for (int o = 1; o < 64; o <<= 1) v += __shfl_xor(v, o);
    return v;
}
__device__ __forceinline__ float silu_f(float x) { return x / (1.f + __expf(-x)); }
__device__ __forceinline__ float gelu_tanh_f(float x) { const float y = 0.7978845608028654f * (x + 0.044715f * x * x * x); return 0.5f * x * (1.f + tanhf(y)); }
__device__ __forceinline__ void ld8(const f16_t* p, float (&o)[8]) { const h8 v = *(const h8*)p;
#pragma unroll
    for (int j = 0; j < 8; ++j) o[j] = (float)v[j]; }

__device__ __forceinline__ void transpose_item(const float* W, int K, int ldw, f16_t* WT, int k0, int dr0, int sc0, int valid, LAS float* scr, int lane) {
    const bool ok = (lane & 31) < valid;
#pragma unroll 8
    for (int i = 0; i < 32; ++i) { const int kk = 2 * i + (lane >> 5); scr[kk * 33 + (lane & 31)] = ok ? W[(size_t)(k0 + kk) * ldw + sc0 + (lane & 31)] : 0.f; }
    LDS_WAIT(); asm volatile("" ::: "memory");
    const int c = lane & 7;
#pragma unroll
    for (int j = 0; j < 4; ++j) { const int n = (lane >> 3) + 8 * j; const LAS float* s = scr + (8 * c) * 33 + n;
        uint4 o; o.x = pk_f16(s[0 * 33], s[1 * 33]); o.y = pk_f16(s[2 * 33], s[3 * 33]); o.z = pk_f16(s[4 * 33], s[5 * 33]); o.w = pk_f16(s[6 * 33], s[7 * 33]);
        *(uint4*)(WT + (size_t)(dr0 + n) * K + k0 + 8 * c) = o; }
    LDS_WAIT(); asm volatile("" ::: "memory");
}
__device__ __forceinline__ void rms_row_to_f16(const float* xrow, const float* w, f16_t* orow, int lane) {
    const float4* xr = (const float4*)xrow + lane; const float4* wr = (const float4*)w + lane;
    float4 v[4]; float s = 0.f;
#pragma unroll
    for (int j = 0; j < 4; ++j) { v[j] = xr[64 * j]; s += (v[j].x * v[j].x + v[j].y * v[j].y) + (v[j].z * v[j].z + v[j].w * v[j].w); }
    const float r = rsqrtf(wave_sum(s) * (1.f / D_MODEL) + NORM_EPS);
    uint2* o8 = (uint2*)orow + lane;
#pragma unroll
    for (int j = 0; j < 4; ++j) { const float4 ww = wr[64 * j]; uint2 o; o.x = pk_f16(v[j].x * r * ww.x, v[j].y * r * ww.y); o.y = pk_f16(v[j].z * r * ww.z, v[j].w * r * ww.w); o8[64 * j] = o; }
}
__device__ __forceinline__ void p0_prologue(const Frame& F, const Args& a) {
    LAS float* scr = (LAS float*)(F.lds + RING_OFF + F.wave * 16384);
    const int gw = F.bid * NWAVES + F.wave, NGW = F.G * NWAVES;
    constexpr int I_IN = 16 * (IN_PAD / 32), I_OUT = 16 * 32, I_UP = 16 * (2 * D_FF / 32), I_DOWN = (D_FF / 64) * 32, I_L = I_IN + I_OUT + I_UP + I_DOWN;
    for (int it = gw; it < DEPTH * I_L; it += NGW) {
        const int l = it / I_L; int r = it % I_L;
        unsigned char* wb = a.ws + WS_W + (size_t)l * W_LAYER;
        if (r < I_IN) { const int kb = r / (IN_PAD / 32), nb = r % (IN_PAD / 32); int valid = IN_WIDTH - 32 * nb; valid = valid < 0 ? 0 : (valid > 32 ? 32 : valid);
            transpose_item(a.in[2] + (size_t)l * D_MODEL * IN_WIDTH, D_MODEL, IN_WIDTH, (f16_t*)(wb + W_IN), 64 * kb, 32 * nb, 32 * nb, valid, scr, F.lane); continue; }
        r -= I_IN;
        if (r < I_OUT) { const int kb = r / 32, nb = r % 32;
            transpose_item(a.in[8] + (size_t)l * D_MODEL * D_MODEL, D_MODEL, D_MODEL, (f16_t*)(wb + W_OUT), 64 * kb, 32 * nb, 32 * nb, 32, scr, F.lane); continue; }
        r -= I_OUT;
        if (r < I_UP) { const int kb = r / (2 * D_FF / 32), nb = r % (2 * D_FF / 32); const int r0 = 32 * nb, tj = r0 >> 8, half = (r0 >> 7) & 1, i0 = r0 & 127;
            transpose_item(a.in[11] + (size_t)l * D_MODEL * 2 * D_FF, D_MODEL, 2 * D_FF, (f16_t*)(wb + W_UP), 64 * kb, r0, half * D_FF + 128 * tj + i0, 32, scr, F.lane); continue; }
        r -= I_UP;
        { const int kb = r / 32, nb = r % 32;
            transpose_item(a.in[14] + (size_t)l * D_FF * D_MODEL, D_FF, D_MODEL, (f16_t*)(wb + W_DOWN), 64 * kb, 32 * nb, 32 * nb, 32, scr, F.lane); }
    }
    f16_t* XN = (f16_t*)(a.ws + WS_XN);
    for (int m = gw; m < T_TOK; m += NGW) rms_row_to_f16(a.in[0] + (size_t)m * D_MODEL, a.in[1], XN + (size_t)m * D_MODEL, F.lane);
}

__device__ __forceinline__ void naive_swa(const Frame& F, const f16_t* proj, const float* sinks, f16_t* mixed) {
    for (int idx = F.bid * NTHREADS + F.tid; idx < T_TOK * 4; idx += F.G * NTHREADS) {
        const int t = idx % SEQ, hq = (idx / SEQ) & 3, b = idx / (SEQ * 4), hkv = hq >> 1;
        const float slope = exp2f(-(float)(2 * hq + 1));
        const size_t rb = (size_t)b * SEQ;
        float q[64], o[64];
#pragma unroll
        for (int i = 0; i < 8; ++i) { float v[8]; ld8(proj + (rb + t) * PROJ_W + COL_QA + hq * 64 + 8 * i, v);
#pragma unroll
            for (int j = 0; j < 8; ++j) q[8 * i + j] = v[j] * 0.125f; }
#pragma unroll
        for (int i = 0; i < 64; ++i) o[i] = 0.f;
        float mx = sinks[hq], l = 1.f;
        const int s0 = t - 127 < 0 ? 0 : t - 127;
        for (int s = s0; s <= t; ++s) {
            const f16_t* kp = proj + (rb + s) * PROJ_W + COL_KA + hkv * 64;
            float d = 0.f;
#pragma unroll
            for (int i = 0; i < 8; ++i) { float v[8]; ld8(kp + 8 * i, v);
#pragma unroll
                for (int j = 0; j < 8; ++j) d = fmaf(q[8 * i + j], v[j], d); }
            const float sc = d - slope * (float)(t - s);
            const float mn = fmaxf(mx, sc), f = __expf(mx - mn), p = __expf(sc - mn);
            mx = mn; l = l * f + p;
            const f16_t* vp = proj + (rb + s) * PROJ_W + COL_VA + hkv * 64;
#pragma unroll
            for (int i = 0; i < 8; ++i) { float v[8]; ld8(vp + 8 * i, v);
#pragma unroll
                for (int j = 0; j < 8; ++j) o[8 * i + j] = fmaf(p, v[j], o[8 * i + j] * f); }
        }
        const float rl = 1.f / l;
        uint4* op = (uint4*)(mixed + (rb + t) * D_MODEL + hq * 64);
#pragma unroll
        for (int i = 0; i < 8; ++i) { uint4 w; w.x = pk_f16(o[8 * i] * rl, o[8 * i + 1] * rl); w.y = pk_f16(o[8 * i + 2] * rl, o[8 * i + 3] * rl); w.z = pk_f16(o[8 * i + 4] * rl, o[8 * i + 5] * rl); w.w = pk_f16(o[8 * i + 6] * rl, o[8 * i + 7] * rl); op[i] = w; }
    }
}
__device__ __forceinline__ void moba_block(const f16_t* projb, int h, int t, int blk, int kend, const float (&q)[64], float slope, float& mx, float& l, float (&o)[64]) {
    for (int i = 0; i < kend; ++i) {
        const int s = blk * 256 + i;
        const f16_t* kp = projb + (size_t)s * PROJ_W + COL_KB + h * 64;
        float d = 0.f;
#pragma unroll
        for (int c = 0; c < 8; ++c) { float v[8]; ld8(kp + 8 * c, v);
#pragma unroll
            for (int j = 0; j < 8; ++j) d = fmaf(q[8 * c + j], v[j], d); }
        const float sc = d * 0.125f - slope * (float)(t - s);
        const float mn = fmaxf(mx, sc), f = __expf(mx - mn), p = __expf(sc - mn);
        mx = mn; l = l * f + p;
        const f16_t* vp = projb + (size_t)s * PROJ_W + COL_VB + h * 64;
#pragma unroll
        for (int c = 0; c < 8; ++c) { float v[8]; ld8(vp + 8 * c, v);
#pragma unroll
            for (int j = 0; j < 8; ++j) o[8 * c + j] = fmaf(p, v[j], o[8 * c + j] * f); }
    }
}
__device__ __forceinline__ void naive_moba(const Frame& F, const f16_t* proj, const float* kmean, f16_t* mixed) {
    for (int idx = F.bid * NTHREADS + F.tid; idx < T_TOK * 4; idx += F.G * NTHREADS) {
        const int t = idx % SEQ, h = (idx / SEQ) & 3, b = idx / (SEQ * 4);
        const float slope = exp2f(-(float)(2 * h + 2));
        const f16_t* projb = proj + (size_t)b * SEQ * PROJ_W;
        float q[64], o[64];
#pragma unroll
        for (int i = 0; i < 8; ++i) { float v[8]; ld8(projb + (size_t)t * PROJ_W + COL_QB + h * 64 + 8 * i, v);
#pragma unroll
            for (int j = 0; j < 8; ++j) q[8 * i + j] = v[j]; }
#pragma unroll
        for (int i = 0; i < 64; ++i) o[i] = 0.f;
        const int own = t >> 8;
        float g0 = -3e38f, g1 = -3e38f, g2 = -3e38f; int i0 = -1, i1 = -1, i2 = -1;
        for (int n = 0; n < own; ++n) {
            const float4* kp = (const float4*)(kmean + (size_t)((b * 4 + h) * 32 + n) * 64);
            float d = 0.f;
#pragma unroll
            for (int j = 0; j < 16; ++j) { const float4 v = kp[j]; d = fmaf(q[4 * j], v.x, d); d = fmaf(q[4 * j + 1], v.y, d); d = fmaf(q[4 * j + 2], v.z, d); d = fmaf(q[4 * j + 3], v.w, d); }
            if (d > g0) { g2 = g1; i2 = i1; g1 = g0; i1 = i0; g0 = d; i0 = n; }
            else if (d > g1) { g2 = g1; i2 = i1; g1 = d; i1 = n; }
            else if (d > g2) { g2 = d; i2 = n; }
        }
        float mx = -1e30f, l = 0.f;
        moba_block(projb, h, t, own, (t & 255) + 1, q, slope, mx, l, o);
        if (i0 >= 0) moba_block(projb, h, t, i0, 256, q, slope, mx, l, o);
        if (i1 >= 0) moba_block(projb, h, t, i1, 256, q, slope, mx, l, o);
        if (i2 >= 0) moba_block(projb, h, t, i2, 256, q, slope, mx, l, o);
        const float rl = 1.f / l;
        uint4* op = (uint4*)(mixed + ((size_t)b * SEQ + t) * D_MODEL + 256 + h * 64);
#pragma unroll
        for (int i = 0; i < 8; ++i) { uint4 w; w.x = pk_f16(o[8 * i] * rl, o[8 * i + 1] * rl); w.y = pk_f16(o[8 * i + 2] * rl, o[8 * i + 3] * rl); w.z = pk_f16(o[8 * i + 4] * rl, o[8 * i + 5] * rl); w.w = pk_f16(o[8 * i + 6] * rl, o[8 * i + 7] * rl); op[i] = w; }
    }
}
__device__ __forceinline__ void naive_dn1(const Frame& F, const f16_t* proj, const float* gates, const float* cw, const float* a_log, const float* dt_bias, f16_t* qkvc, float* beta, float* g) {
    const int gw = F.bid * NWAVES + F.wave, NGW = F.G * NWAVES;
    for (int item = gw; item < T_TOK * 4; item += NGW) {
        const int bt = item >> 2, h = item & 3, t = bt % SEQ;
        float val[3][2];
#pragma unroll
        for (int m = 0; m < 3; ++m) {
            const int c = m * 512 + h * 128 + 2 * F.lane;
            float a0 = 0.f, a1 = 0.f;
#pragma unroll
            for (int i = 0; i < 4; ++i) { const int tt = t - 3 + i;
                if (tt >= 0) { const h2 x = *(const h2*)(proj + (size_t)(bt - 3 + i) * PROJ_W + COL_QKVC + c); const float2 w = *(const float2*)(cw + i * 1536 + c);
                    a0 = fmaf(w.x, (float)x[0], a0); a1 = fmaf(w.y, (float)x[1], a1); } }
            val[m][0] = silu_f(a0); val[m][1] = silu_f(a1);
        }
#pragma unroll
        for (int m = 0; m < 2; ++m) { const float r = rsqrtf(wave_sum(val[m][0] * val[m][0] + val[m][1] * val[m][1]) + NORM_EPS); val[m][0] *= r; val[m][1] *= r; }
#pragma unroll
        for (int m = 0; m < 3; ++m) *(unsigned*)(qkvc + (size_t)bt * 1536 + m * 512 + h * 128 + 2 * F.lane) = pk_f16(val[m][0], val[m][1]);
        if (F.lane == 0) {
            const float bc = gates[(size_t)bt * 8 + h], ac = gates[(size_t)bt * 8 + 4 + h] + dt_bias[h];
            beta[bt * 4 + h] = 1.f / (1.f + expf(-bc));
            const float sp = ac > 20.f ? ac : log1pf(expf(ac));
            g[bt * 4 + h] = -expf(a_log[h]) * sp;
        }
    }
}
__device__ __forceinline__ void naive_dn2(const Frame& F, const f16_t* qkvc, const float* beta, const float* g, f16_t* oc) {
    if (F.bid >= 64) return;
    const int b = F.bid >> 4, h = (F.bid >> 2) & 3, cg = F.bid & 3;
    const int dp = F.tid & 15, e = cg * 32 + (F.tid >> 4);
    float s[8];
#pragma unroll
    for (int i = 0; i < 8; ++i) s[i] = 0.f;
    const size_t r0 = (size_t)b * SEQ;
    const f16_t* qb = qkvc + r0 * 1536 + h * 128 + dp * 8;
    const f16_t* kb = qb + 512;
    const f16_t* vb = qkvc + r0 * 1536 + 1024 + h * 128 + e;
    h8 kn = *(const h8*)kb, qn = *(const h8*)qb; f16_t vn = *vb; float bn = beta[r0 * 4 + h], gn = g[r0 * 4 + h];
    const float qscale = 0.08838834764831845f;
    for (int t = 0; t < SEQ; ++t) {
        const h8 ck = kn, cq = qn; const float cv = h2f(vn), cb = bn, eg = __expf(gn);
        if (t + 1 < SEQ) { const size_t off = (size_t)(t + 1) * 1536; kn = *(const h8*)(kb + off); qn = *(const h8*)(qb + off); vn = vb[off]; bn = beta[(r0 + t + 1) * 4 + h]; gn = g[(r0 + t + 1) * 4 + h]; }
        float ks = 0.f;
#pragma unroll
        for (int i = 0; i < 8; ++i) { s[i] *= eg; ks = fmaf((float)ck[i], s[i], ks); }
        ks += __shfl_xor(ks, 1); ks += __shfl_xor(ks, 2); ks += __shfl_xor(ks, 4); ks += __shfl_xor(ks, 8);
        const float c = cb * (cv - ks);
        float o = 0.f;
#pragma unroll
        for (int i = 0; i < 8; ++i) { s[i] = fmaf((float)ck[i], c, s[i]); o = fmaf((float)cq[i], s[i], o); }
        o += __shfl_xor(o, 1); o += __shfl_xor(o, 2); o += __shfl_xor(o, 4); o += __shfl_xor(o, 8);
        if (dp == 0) oc[(r0 + t) * 512 + h * 128 + e] = f2h(o * qscale);
    }
}
__device__ __forceinline__ void naive_dn3(const Frame& F, const f16_t* oc, const f16_t* proj, const float* nw, f16_t* mixed) {
    const int gw = F.bid * NWAVES + F.wave, NGW = F.G * NWAVES;
    for (int item = gw; item < T_TOK * 4; item += NGW) {
        const int bt = item >> 2, h = item & 3;
        const h2 v = *(const h2*)(oc + (size_t)bt * 512 + h * 128 + 2 * F.lane);
        const float v0 = (float)v[0], v1 = (float)v[1];
        const float r = rsqrtf(wave_sum(v0 * v0 + v1 * v1) * (1.f / 128.f) + NORM_EPS);
        const h2 z = *(const h2*)(proj + (size_t)bt * PROJ_W + COL_Z + h * 128 + 2 * F.lane);
        const float2 w = *(const float2*)(nw + 2 * F.lane);
        *(unsigned*)(mixed + (size_t)bt * D_MODEL + 512 + h * 128 + 2 * F.lane) = pk_f16(v0 * r * w.x * silu_f((float)z[0]), v1 * r * w.y * silu_f((float)z[1]));
    }
}
__device__ __forceinline__ void naive_add_norm(const Frame& F, const float* xin, const float* y, const float* w, float* xout, const float* w2, f16_t* xn) {
    const int gw = F.bid * NWAVES + F.wave, NGW = F.G * NWAVES;
    for (int m = gw; m < T_TOK; m += NGW) {
        const float4* yr = (const float4*)(y + (size_t)m * D_MODEL) + F.lane; const float4* xr = (const float4*)(xin + (size_t)m * D_MODEL) + F.lane; const float4* wr = (const float4*)w + F.lane;
        float4 v[4]; float s = 0.f;
#pragma unroll
        for (int j = 0; j < 4; ++j) { v[j] = yr[64 * j]; s += (v[j].x * v[j].x + v[j].y * v[j].y) + (v[j].z * v[j].z + v[j].w * v[j].w); }
        const float r = rsqrtf(wave_sum(s) * (1.f / D_MODEL) + NORM_EPS);
        float4* orow = (float4*)(xout + (size_t)m * D_MODEL) + F.lane; float s2 = 0.f;
#pragma unroll
        for (int j = 0; j < 4; ++j) { const float4 ww = wr[64 * j], xx = xr[64 * j]; float4 o; o.x = xx.x + v[j].x * r * ww.x; o.y = xx.y + v[j].y * r * ww.y; o.z = xx.z + v[j].z * r * ww.z; o.w = xx.w + v[j].w * r * ww.w;
            orow[64 * j] = o; v[j] = o; s2 += (o.x * o.x + o.y * o.y) + (o.z * o.z + o.w * o.w); }
        if (xn) {
            const float r2 = rsqrtf(wave_sum(s2) * (1.f / D_MODEL) + NORM_EPS);
            const float4* w2r = (const float4*)w2 + F.lane; uint2* o8 = (uint2*)(xn + (size_t)m * D_MODEL) + F.lane;
#pragma unroll
            for (int j = 0; j < 4; ++j) { const float4 ww = w2r[64 * j]; uint2 o; o.x = pk_f16(v[j].x * r2 * ww.x, v[j].y * r2 * ww.y); o.y = pk_f16(v[j].z * r2 * ww.z, v[j].w * r2 * ww.w); o8[64 * j] = o; }
        }
    }
}
__device__ __forceinline__ void naive_conv_glu(const Frame& F, const f16_t* ub, const float* cw, const float* cb, f16_t* actb) {
    for (int idx = F.bid * NTHREADS + F.tid; idx < SEQ * 704; idx += F.G * NTHREADS) {
        const int t = idx / 704, j = (idx % 704) * 4, uc = (j >> 7) * 256 + (j & 127);
        float ga[4], ua[4];
        { const float4 a = *(const float4*)(cb + j), c = *(const float4*)(cb + D_FF + j); ga[0] = a.x; ga[1] = a.y; ga[2] = a.z; ga[3] = a.w; ua[0] = c.x; ua[1] = c.y; ua[2] = c.z; ua[3] = c.w; }
#pragma unroll
        for (int i = 0; i < 3; ++i) { const int tt = t - 2 + i;
            if (tt >= 0) { const h4 xg = *(const h4*)(ub + (size_t)tt * (2 * D_FF) + uc), xu = *(const h4*)(ub + (size_t)tt * (2 * D_FF) + uc + 128);
                const float4 wg = *(const float4*)(cw + i * (2 * D_FF) + j), wu = *(const float4*)(cw + i * (2 * D_FF) + D_FF + j);
                ga[0] = fmaf(wg.x, (float)xg[0], ga[0]); ga[1] = fmaf(wg.y, (float)xg[1], ga[1]); ga[2] = fmaf(wg.z, (float)xg[2], ga[2]); ga[3] = fmaf(wg.w, (float)xg[3], ga[3]);
                ua[0] = fmaf(wu.x, (float)xu[0], ua[0]); ua[1] = fmaf(wu.y, (float)xu[1], ua[1]); ua[2] = fmaf(wu.z, (float)xu[2], ua[2]); ua[3] = fmaf(wu.w, (float)xu[3], ua[3]); } }
        uint2 o; o.x = pk_f16(gelu_tanh_f(ga[0]) * ua[0], gelu_tanh_f(ga[1]) * ua[1]); o.y = pk_f16(gelu_tanh_f(ga[2]) * ua[2], gelu_tanh_f(ga[3]) * ua[3]);
        *(uint2*)(actb + (size_t)t * D_FF + j) = o;
    }
}

__global__ void __launch_bounds__(NTHREADS, 2) fwd_kernel(Args args) {
    extern __shared__ __attribute__((aligned(16))) unsigned char lds[];
    Frame F;
    F.lds = (LAS unsigned char*)lds;
    F.tid = threadIdx.x; F.lane = F.tid & 63; F.wave = __builtin_amdgcn_readfirstlane(F.tid >> 6);
    F.G = gridDim.x; F.bid = blockIdx.x;
    gu32* ctl0 = (gu32*)(args.ws + WS_CTL);
    for (int u = F.tid; u < (LDS_BYTES - LDSCTL_OFF) / 4; u += NTHREADS) ((LAS unsigned*)(F.lds + LDSCTL_OFF))[u] = 0u;
    __syncthreads();
    XcdBarrier bar = xcd_barrier_post((unsigned*)(ctl0 + CW_BAR), (volatile LAS unsigned*)(F.lds + MISC_OFF) + 8);
#define GRID_BAR() xcd_barrier(bar)

    p0_prologue(F, args);
    GRID_BAR();
    constexpr int PH_PER_LAYER = 16, NPH = DEPTH * PH_PER_LAYER;
    for (int ph = 0; ph < NPH; ++ph) {
        int p = ph; asm volatile("" : "+s"(p));
        { int t_ = threadIdx.x; asm volatile("" : "+v"(t_)); F.tid = t_; F.lane = t_ & 63; F.wave = __builtin_amdgcn_readfirstlane(t_ >> 6); }
        { int b_ = blockIdx.x, g_ = gridDim.x; asm volatile("" : "+s"(b_), "+s"(g_)); F.bid = b_; F.G = g_; }
        unsigned char* ws = args.ws; asm volatile("" : "+s"(ws));
        gu32* ctl = (gu32*)(ws + WS_CTL);
        f16_t* XN = (f16_t*)(ws + WS_XN); f16_t* PROJ = (f16_t*)(ws + WS_PROJ); f16_t* MIXED = (f16_t*)(ws + WS_MIXED); f16_t* ACT = (f16_t*)(ws + WS_ACT);
        float* GATES = (float*)(ws + WS_GATES); float* BETA = (float*)(ws + WS_BG); float* GG = BETA + (size_t)T_TOK * 4;
        f16_t* QKVC = (f16_t*)(ws + WS_QKVC); f16_t* OC = (f16_t*)(ws + WS_OC); float* Y1 = (float*)(ws + WS_Y1); float* Y2 = (float*)(ws + WS_Y2); f16_t* UB = (f16_t*)(ws + WS_UB);
        const int l = p / PH_PER_LAYER, k = p % PH_PER_LAYER;
        unsigned char* wb = ws + WS_W + (size_t)l * W_LAYER;
        float* kmean = (float*)(ctl + CW_KMEAN) + (size_t)l * 32768;
        if (k == 0) {
            pg8::Gemm g{XN, (const f16_t*)(wb + W_IN), T_TOK, IN_PAD, D_MODEL}; pg8::StaticOrder S; S.init(T_TOK, IN_PAD, F.G, F.bid);
            pg8::EpiProj E{PROJ, GATES, kmean};
            pg8::gemm_phase<pg8::EpiProj, pg8::StaticOrder, true, true>(F.lds + RING_OFF, g, S, E);
        } else if (k == 1) {
            naive_swa(F, PROJ, args.in[3] + l * 4, MIXED);
            naive_moba(F, PROJ, kmean, MIXED);
            naive_dn1(F, PROJ, GATES, args.in[4] + (size_t)l * 4 * 1536, args.in[5] + l * 4, args.in[6] + l * 4, QKVC, BETA, GG);
        } else if (k == 2) {
            naive_dn2(F, QKVC, BETA, GG, OC);
        } else if (k == 3) {
            naive_dn3(F, OC, PROJ, args.in[7] + l * 128, MIXED);
        } else if (k == 4) {
            pg8::Gemm g{MIXED, (const f16_t*)(wb + W_OUT), T_TOK, D_MODEL, D_MODEL}; pg8::StaticOrder S; S.init(T_TOK, D_MODEL, F.G, F.bid);
            pg8::EpiF32 E{Y1, D_MODEL};
            pg8::gemm_phase<pg8::EpiF32, pg8::StaticOrder, true, true>(F.lds + RING_OFF, g, S, E);
        } else if (k == 5) {
            naive_add_norm(F, l == 0 ? args.in[0] : args.out, Y1, args.in[9] + l * D_MODEL, args.out, args.in[10] + l * D_MODEL, XN);
        } else if (k < 14) {
            const int b = (k - 6) >> 1;
            if (((k - 6) & 1) == 0) {
                pg8::Gemm g{XN + (size_t)b * SEQ * D_MODEL, (const f16_t*)(wb + W_UP), SEQ, 2 * D_FF, D_MODEL}; pg8::StaticOrder S; S.init(SEQ, 2 * D_FF, F.G, F.bid);
                pg8::EpiF16 E{UB, 2 * D_FF};
                pg8::gemm_phase<pg8::EpiF16, pg8::StaticOrder, true, true>(F.lds + RING_OFF, g, S, E);
            } else {
                naive_conv_glu(F, UB, args.in[12] + (size_t)l * 3 * 2 * D_FF, args.in[13] + (size_t)l * 2 * D_FF, ACT + (size_t)b * SEQ * D_FF);
            }
        } else if (k == 14) {
            pg8::Gemm g{ACT, (const f16_t*)(wb + W_DOWN), T_TOK, D_MODEL, D_FF}; pg8::StaticOrder S; S.init(T_TOK, D_MODEL, F.G, F.bid);
            pg8::EpiF32 E{Y2, D_MODEL};
            pg8::gemm_phase<pg8::EpiF32, pg8::StaticOrder, true, true>(F.lds + RING_OFF, g, S, E);
        } else {
            naive_add_norm(F, args.out, Y2, args.in[15] + l * D_MODEL, args.out, l + 1 < DEPTH ? args.in[1] + (l + 1) * D_MODEL : nullptr, l + 1 < DEPTH ? XN : nullptr);
        }
        if (ph + 1 < NPH) GRID_BAR();
    }
}

extern "C" void kernel_launch(void* const* d_in, const int* in_sizes, int n_in, void* d_out, int out_size, void* d_ws, size_t ws_size, hipStream_t stream) {
    static int grid = 0;
    if (grid == 0) {
        if (n_in != 16 || ws_size < WS_END) { fprintf(stderr, "kernel_launch: unexpected n_in %d or ws_size %zu (< %zu)\n", n_in, ws_size, (size_t)WS_END); grid = -1; return; }
        int dev = 0, cus = 0, per_cu = 0;
        if (hipGetDevice(&dev) != hipSuccess || hipDeviceGetAttribute(&cus, hipDeviceAttributeMultiprocessorCount, dev) != hipSuccess) { grid = -1; return; }
        if (hipFuncSetAttribute((const void*)fwd_kernel, hipFuncAttributeMaxDynamicSharedMemorySize, LDS_BYTES) != hipSuccess) { fprintf(stderr, "kernel_launch: hipFuncSetAttribute failed\n"); grid = -1; return; }
        if (hipOccupancyMaxActiveBlocksPerMultiprocessor(&per_cu, (const void*)fwd_kernel, NTHREADS, LDS_BYTES) != hipSuccess || per_cu < 1) { fprintf(stderr, "kernel_launch: occupancy query failed (%d)\n", per_cu); (void)hipGetLastError(); per_cu = 1; }
        grid = cus * 1;
        if (per_cu < 1) grid = -1;
    }
    if (grid < 0) return;
    if (hipMemsetAsync((char*)d_ws + WS_CTL, 0, CTL_ZERO_BYTES, stream) != hipSuccess) return;
    Args a{};
    for (int i = 0; i < 16; ++i) a.in[i] = (const float*)d_in[i];
    a.out = (float*)d_out; a.ws = (unsigned char*)d_ws;
    hipLaunchKernelGGL(fwd_kernel, dim3(grid), dim3(NTHREADS), LDS_BYTES, stream, a);
}
```

```cpp
#include <hip/hip_runtime.h>
#include <cstdio>
#include <cstdint>

constexpr int D_MODEL = 1024, BATCH = 4, SEQ = 8192, DEPTH = 2, T_TOK = BATCH * SEQ;
constexpr int IN_WIDTH = 3336, IN_PAD = 3584, PROJ_W = 3328, D_FF = 2816;
constexpr int COL_QA = 0, COL_KA = 256, COL_VA = 384, COL_QB = 512, COL_KB = 768, COL_VB = 1024, COL_QKVC = 1280, COL_Z = 2816;
constexpr float NORM_EPS = 1e-6f;
constexpr int NWAVES = 8, NTHREADS = 512;

constexpr size_t MiB = 1u << 20;
constexpr size_t WS_CTL = 0, CTL_ZERO_BYTES = 1 * MiB;
constexpr size_t WS_GATES = 1 * MiB;
constexpr size_t WS_SEL = 2 * MiB;
constexpr size_t WS_BG = 3 * MiB;
constexpr size_t WS_W = 4 * MiB, W_LAYER = 26 * MiB;
constexpr size_t W_IN = 0, W_OUT = 7 * MiB, W_UP = 9 * MiB, W_DOWN = 20 * MiB;
constexpr size_t WS_XN = 56 * MiB;
constexpr size_t WS_DNI = 56 * MiB;
constexpr size_t WS_PROJ = 200 * MiB;
constexpr size_t WS_ACT = 200 * MiB;
constexpr size_t WS_MIXED = 408 * MiB;
constexpr size_t WS_SPARE = 472 * MiB;
constexpr size_t WS_END = 512 * MiB;
constexpr size_t WS_QKVC = 56 * MiB;
constexpr size_t WS_OC = WS_SPARE;
constexpr size_t WS_Y1 = WS_PROJ;
constexpr size_t WS_Y2 = 376 * MiB;
constexpr size_t WS_UB = 408 * MiB;
constexpr int CW_BAR = 4096;
constexpr int CW_KMEAN = 131072;
static_assert((CW_KMEAN + 2 * 32768) * 4 <= (int)CTL_ZERO_BYTES, "ctl");

constexpr int RING_OFF = 0, RING_BYTES = 131072;
constexpr int LDS_BYTES = 163840;
constexpr int LDSCTL_OFF = LDS_BYTES - 1024, MISC_OFF = LDSCTL_OFF + 320;

typedef unsigned short f16_t;
typedef _Float16 h8 __attribute__((ext_vector_type(8)));
typedef _Float16 h4 __attribute__((ext_vector_type(4)));
typedef _Float16 h2 __attribute__((ext_vector_type(2)));
__device__ __forceinline__ unsigned pk_f16(float lo, float hi) { h2 v = {(_Float16)lo, (_Float16)hi}; return __builtin_bit_cast(unsigned, v); }
__device__ __forceinline__ float h2f(f16_t b) { return (float)__builtin_bit_cast(_Float16, b); }
__device__ __forceinline__ f16_t f2h(float f) { return __builtin_bit_cast(f16_t, (_Float16)f); }

namespace pg8 {
#define PG8_LAS __attribute__((address_space(3)))
typedef unsigned short bf16_t;
typedef _Float16 bf16x8 __attribute__((ext_vector_type(8)));
typedef float f32x4 __attribute__((ext_vector_type(4)));
typedef unsigned u32x4 __attribute__((ext_vector_type(4)));
constexpr int BM = 256, BK = 64, HALF = 128, HTB = HALF * BK * 2  , STAGE_BYTES = 8 * HTB, NXCD = 8, WGM = 8;

__host__ __device__ __forceinline__ int lds_byte(int r, int c) { const int st = (r >> 4) * 2 + (c >> 5), rr = r & 15, cc = c & 31, ob = rr * 64 + cc * 2; return st * 1024 + (ob ^ (((ob >> 9) & 1) << 5)); }
__host__ __device__ __forceinline__ void stage_rc(int b, int& R, int& C) { const int st = b / 1024, sb = b % 1024, swz = sb ^ (((sb >> 9) & 1) << 5); R = (st >> 1) * 16 + swz / 64; C = (st & 1) * 32 + (swz % 64) / 2; }
__host__ __device__ __forceinline__ int perm32(int rho) { const int n = rho >> 4, i = rho & 15; return 8 * (i >> 2) + 4 * n + (i & 3); }

struct Unit { int pm, pn; };
struct Gemm { const bf16_t* A; const bf16_t* Bt; int M, N, K; };

struct StaticOrder {
    int nM, nN, nwg, G, c;
    __host__ __device__ void init(int M, int N, int G_, int c_) { nM = M / BM; nN = N / BM; nwg = nM * nN; G = G_; c = c_; }
    __host__ __device__ bool next(int i, Unit& u) const {
        const long L = (long)i * G + c; if (L >= nwg) return false;
        int wgid = (int)L; { const int q = nwg / NXCD, r = nwg % NXCD, xcd = wgid % NXCD, off = wgid / NXCD; wgid = (xcd < r ? xcd * (q + 1) : r * (q + 1) + (xcd - r) * q) + off; }
        const int nig = WGM * nN, gid = wgid / nig, fm = gid * WGM, gsz = (nM - fm) < WGM ? (nM - fm) : WGM;
        u.pm = fm + ((wgid % nig) % gsz); u.pn = (wgid % nig) / gsz; return true;
    }
    __device__ __forceinline__ void a_ready(const Unit&) const {}
    __device__ __forceinline__ void done(const Unit&) const {}
};

struct EpiF32 {
    static constexpr bool PERM = false, AFTER_DRAIN = false;
    float* C; int ldc;
    __device__ __forceinline__ void operator()(const f32x4 (&acc)[2][2][4][2], const Unit& u, int wr, int wc, int fr, int fq) const {
        const int row0 = u.pm * BM + wr * 64 + fr, col0 = u.pn * BM + wc * 32 + 4 * fq;
#pragma unroll
        for (int ai = 0; ai < 2; ++ai)
#pragma unroll
            for (int m = 0; m < 4; ++m) { float* rowp = C + (size_t)(row0 + ai * HALF + m * 16) * ldc + col0;
#pragma unroll
                for (int bj = 0; bj < 2; ++bj)
#pragma unroll
                    for (int n = 0; n < 2; ++n) *(f32x4*)(rowp + bj * HALF + n * 16) = acc[ai][bj][m][n]; }
    }
};
struct EpiF16 {
    static constexpr bool PERM = true, AFTER_DRAIN = false;
    bf16_t* O; int ldc;
    __device__ __forceinline__ void operator()(const f32x4 (&acc)[2][2][4][2], const Unit& u, int wr, int wc, int fr, int fq) const {
        const int row0 = u.pm * BM + wr * 64 + fr, col0 = u.pn * BM + wc * 32 + 8 * fq;
#pragma unroll
        for (int ai = 0; ai < 2; ++ai)
#pragma unroll
            for (int m = 0; m < 4; ++m) { bf16_t* rowp = O + (size_t)(row0 + ai * HALF + m * 16) * ldc + col0;
#pragma unroll
                for (int bj = 0; bj < 2; ++bj) { const f32x4 v0 = acc[ai][bj][m][0], v1 = acc[ai][bj][m][1];
                    u32x4 w; w.x = pk_f16(v0[0], v0[1]); w.y = pk_f16(v0[2], v0[3]); w.z = pk_f16(v1[0], v1[1]); w.w = pk_f16(v1[2], v1[3]);
                    *(u32x4*)(rowp + bj * HALF) = w; } }
    }
};
struct EpiProj {
    static constexpr bool PERM = true, AFTER_DRAIN = false;
    bf16_t* P; float* gates; float* kmean;
    __device__ __forceinline__ void operator()(const f32x4 (&acc)[2][2][4][2], const Unit& u, int wr, int wc, int fr, int fq) const {
        const int row0 = u.pm * BM + wr * 64 + fr;
        if (u.pn < 13) {
            const int col0 = u.pn * BM + wc * 32 + 8 * fq;
#pragma unroll
            for (int ai = 0; ai < 2; ++ai)
#pragma unroll
                for (int m = 0; m < 4; ++m) { bf16_t* rowp = P + (size_t)(row0 + ai * HALF + m * 16) * PROJ_W + col0;
#pragma unroll
                    for (int bj = 0; bj < 2; ++bj) { const f32x4 v0 = acc[ai][bj][m][0], v1 = acc[ai][bj][m][1];
                        u32x4 w; w.x = pk_f16(v0[0], v0[1]); w.y = pk_f16(v0[2], v0[3]); w.z = pk_f16(v1[0], v1[1]); w.w = pk_f16(v1[2], v1[3]);
                        *(u32x4*)(rowp + bj * HALF) = w; } }
            if (u.pn == 3) {
                const int b = u.pm >> 5, nb = u.pm & 31;
#pragma unroll
                for (int bj = 0; bj < 2; ++bj)
#pragma unroll
                    for (int n = 0; n < 2; ++n) {
                        f32x4 s = {0.f, 0.f, 0.f, 0.f};
#pragma unroll
                        for (int ai = 0; ai < 2; ++ai)
#pragma unroll
                            for (int m = 0; m < 4; ++m) s += acc[ai][bj][m][n];
#pragma unroll
                        for (int j = 0; j < 4; ++j) { float v = s[j]; v += __shfl_xor(v, 1); v += __shfl_xor(v, 2); v += __shfl_xor(v, 4); v += __shfl_xor(v, 8); s[j] = v; }
                        if (fr == 0) { const int c = 128 * bj + 32 * wc + 8 * fq + 4 * n, h = c >> 6, d = c & 63; float* kp = kmean + (size_t)((b * 4 + h) * 32 + nb) * 64 + d;
#pragma unroll
                            for (int j = 0; j < 4; ++j) atomicAdd(kp + j, s[j] * (1.0f / 256.0f)); }
                    }
            }
        } else if (wc == 0 && fq == 0) {
#pragma unroll
            for (int ai = 0; ai < 2; ++ai)
#pragma unroll
                for (int m = 0; m < 4; ++m) { float* gp = gates + (size_t)(row0 + ai * HALF + m * 16) * 8;
                    *(f32x4*)gp = acc[ai][0][m][0]; *(f32x4*)(gp + 4) = acc[ai][0][m][1]; }
        }
    }
};

template <class Epi, class Sched, bool ALIGN_EPI = false, bool SP2 = false>
__device__ __forceinline__ void gemm_phase(PG8_LAS unsigned char* lds, const Gemm g, const Sched& S, const Epi& E) {
    int tid_ = threadIdx.x; asm volatile("" : "+v"(tid_));
    const int tid = tid_, wid = __builtin_amdgcn_readfirstlane(tid >> 6), lane = tid & 63, wr = wid >> 2, wc = wid & 3, fr = lane & 15, fq = lane >> 4;
    const int K = g.K, nt = K / BK;
    unsigned voffA[2], voffB[2];
#pragma unroll
    for (int i = 0; i < 2; ++i) { int R, C; stage_rc(tid * 16 + i * 8192, R, C); const int Rb = Epi::PERM ? ((R & ~31) + perm32(R & 31)) : R;
        voffA[i] = (unsigned)(R * K + C) * 2u; voffB[i] = (unsigned)(Rb * K + C) * 2u; }
    const size_t kstep = (size_t)(BK * 2);
    const size_t hstep = (size_t)HALF * K * 2;
    const size_t tstep = 2 * hstep;
    const unsigned ldsw = (unsigned)wid * 1024u;
    const int aoff = lds_byte(wr * 64 + fr, fq * 8), boff = lds_byte(wc * 32 + fr, fq * 8);
#define PG8_SA(b, h) (((b) * 2 + (h)) * HTB)
#define PG8_SB(b, h) ((4 + (b) * 2 + (h)) * HTB)
#define PG8_STAGE(bufoff, gbase, voff) do { _Pragma("unroll") for (int _i = 0; _i < 2; ++_i) \
        __builtin_amdgcn_global_load_lds((const unsigned*)((const char*)(gbase) + (voff)[_i]), (PG8_LAS unsigned*)(lds + (bufoff) + ldsw + _i * 8192), 16, 0, 0); } while (0)
#define PG8_LDA(dst, b, h) do { _Pragma("unroll") for (int m = 0; m < 4; ++m) _Pragma("unroll") for (int k = 0; k < 2; ++k) dst[m][k] = *(const PG8_LAS bf16x8*)(lds + PG8_SA(b, h) + aoff + m * 2048 + k * 1024); } while (0)
#define PG8_LDB(dst, b, h) do { _Pragma("unroll") for (int n = 0; n < 2; ++n) _Pragma("unroll") for (int k = 0; k < 2; ++k) dst[n][k] = *(const PG8_LAS bf16x8*)(lds + PG8_SB(b, h) + boff + n * 2048 + k * 1024); } while (0)
#define PG8_MMA(ai, bj, At, Bt) do { __builtin_amdgcn_s_setprio(1); _Pragma("unroll") for (int m = 0; m < 4; ++m) _Pragma("unroll") for (int n = 0; n < 2; ++n) _Pragma("unroll") for (int k = 0; k < 2; ++k) \
        acc[ai][bj][m][n] = __builtin_amdgcn_mfma_f32_16x16x32_f16(Bt[n][k], At[m][k], acc[ai][bj][m][n], 0, 0, 0); __builtin_amdgcn_s_setprio(0); } while (0)
#define PG8_WAIT_V(n) asm volatile("s_waitcnt vmcnt(" #n ")" ::: "memory")
#define PG8_WAIT_L(n) asm volatile("s_waitcnt lgkmcnt(" #n ")" ::: "memory")
#define PG8_BAR __builtin_amdgcn_s_barrier()
#define PG8_SCHED __builtin_amdgcn_sched_barrier(0)
    Unit cur, nxt; int ui = 0;
    if (!S.next(0, cur)) return;
    f32x4 acc[2][2][4][2];
#pragma unroll
    for (int a = 0; a < 2; ++a)
#pragma unroll
        for (int b = 0; b < 2; ++b)
#pragma unroll
            for (int m = 0; m < 4; ++m)
#pragma unroll
                for (int n = 0; n < 2; ++n) acc[a][b][m][n] = (f32x4){0.f, 0.f, 0.f, 0.f};
    bf16x8 At[4][2], B0[2][2], B1[2][2];
    const char* cA = (const char*)g.A + (size_t)cur.pm * tstep; const char* cB = (const char*)g.Bt + (size_t)cur.pn * tstep;
    S.a_ready(cur);
    if constexpr (SP2) {
        PG8_STAGE(PG8_SB(0, 0), cB, voffB); PG8_STAGE(PG8_SB(0, 1), cB + hstep, voffB); PG8_STAGE(PG8_SA(0, 0), cA, voffA); PG8_STAGE(PG8_SA(0, 1), cA + hstep, voffA);
        if (wr == 1) PG8_BAR;
        PG8_WAIT_V(2); PG8_BAR;
        PG8_STAGE(PG8_SB(1, 0), cB + kstep, voffB); PG8_STAGE(PG8_SA(1, 0), cA + kstep, voffA); PG8_STAGE(PG8_SB(1, 1), cB + hstep + kstep, voffB);
        PG8_WAIT_V(6); PG8_BAR;
    } else {
        PG8_STAGE(PG8_SB(0, 0), cB, voffB); PG8_STAGE(PG8_SA(0, 0), cA, voffA); PG8_STAGE(PG8_SB(0, 1), cB + hstep, voffB); PG8_STAGE(PG8_SA(0, 1), cA + hstep, voffA);
        if (wr == 1) PG8_BAR;
        PG8_WAIT_V(4); PG8_BAR;
        PG8_STAGE(PG8_SB(1, 0), cB + kstep, voffB); PG8_STAGE(PG8_SA(1, 0), cA + kstep, voffA); PG8_STAGE(PG8_SB(1, 1), cB + hstep + kstep, voffB);
        PG8_WAIT_V(6); PG8_BAR;
    }
    for (;;) {
        const bool has_next = S.next(ui + 1, nxt);
        const char* nA = has_next ? (const char*)g.A + (size_t)nxt.pm * tstep : cA; const char* nB = has_next ? (const char*)g.Bt + (size_t)nxt.pn * tstep : cB;
        for (int t = 0; t < nt; t += 2) {
            const bool last = (t == nt - 2);
            const char* a1 = cA + (size_t)(t + 1) * kstep;
            const char* a2 = last ? nA : cA + (size_t)(t + 2) * kstep; const char* b2 = last ? nB : cB + (size_t)(t + 2) * kstep;
            const char* a3 = a2 + kstep; const char* b3 = b2 + kstep;
            if (last && has_next) S.a_ready(nxt);
            if constexpr (SP2) {
            PG8_LDB(B0, 0, 0); PG8_LDB(B1, 0, 1); PG8_SCHED; PG8_LDA(At, 0, 0); PG8_STAGE(PG8_SA(1, 1), a1 + hstep, voffA);
            PG8_WAIT_V(8); PG8_WAIT_L(0); PG8_BAR; PG8_MMA(0, 0, At, B0); PG8_MMA(0, 1, At, B1); PG8_BAR; PG8_SCHED;
            PG8_LDA(At, 0, 1); PG8_STAGE(PG8_SB(0, 0), b2, voffB); PG8_STAGE(PG8_SB(0, 1), b2 + hstep, voffB); PG8_STAGE(PG8_SA(0, 0), a2, voffA);
            PG8_WAIT_V(8); PG8_WAIT_L(0); PG8_BAR; PG8_MMA(1, 0, At, B0); PG8_MMA(1, 1, At, B1); PG8_BAR; PG8_SCHED;
            PG8_LDB(B0, 1, 0); PG8_LDB(B1, 1, 1); PG8_SCHED; PG8_LDA(At, 1, 0); PG8_STAGE(PG8_SA(0, 1), a2 + hstep, voffA);
            PG8_WAIT_V(8); PG8_WAIT_L(0); PG8_BAR; PG8_MMA(0, 0, At, B0); PG8_MMA(0, 1, At, B1); PG8_BAR; PG8_SCHED;
            PG8_LDA(At, 1, 1); PG8_STAGE(PG8_SB(1, 0), b3, voffB); PG8_STAGE(PG8_SB(1, 1), b3 + hstep, voffB); PG8_STAGE(PG8_SA(1, 0), a3, voffA);
            PG8_WAIT_V(8); PG8_WAIT_L(0); PG8_BAR; PG8_MMA(1, 0, At, B0); PG8_MMA(1, 1, At, B1); PG8_BAR; PG8_SCHED;
            } else {
            PG8_LDB(B0, 0, 0); PG8_SCHED; PG8_LDA(At, 0, 0); PG8_STAGE(PG8_SA(1, 1), a1 + hstep, voffA);
            PG8_WAIT_L(8); PG8_BAR; PG8_WAIT_L(0); PG8_MMA(0, 0, At, B0); PG8_BAR; PG8_SCHED;
            PG8_LDB(B1, 0, 1); PG8_STAGE(PG8_SB(0, 0), b2, voffB);
            PG8_BAR; PG8_WAIT_L(0); PG8_MMA(0, 1, At, B1); PG8_BAR;
            PG8_LDA(At, 0, 1); PG8_STAGE(PG8_SA(0, 0), a2, voffA);
            PG8_BAR; PG8_WAIT_L(0); PG8_MMA(1, 0, At, B0); PG8_BAR; PG8_SCHED;
            PG8_STAGE(PG8_SB(0, 1), b2 + hstep, voffB);
            PG8_WAIT_V(6); PG8_BAR; PG8_MMA(1, 1, At, B1); PG8_BAR;
            PG8_LDB(B0, 1, 0); PG8_SCHED; PG8_LDA(At, 1, 0); PG8_STAGE(PG8_SA(0, 1), a2 + hstep, voffA);
            PG8_WAIT_L(8); PG8_BAR; PG8_WAIT_L(0); PG8_MMA(0, 0, At, B0); PG8_BAR; PG8_SCHED;
            PG8_LDB(B1, 1, 1); PG8_STAGE(PG8_SB(1, 0), b3, voffB);
            PG8_BAR; PG8_WAIT_L(0); PG8_MMA(0, 1, At, B1); PG8_BAR;
            PG8_LDA(At, 1, 1); PG8_STAGE(PG8_SA(1, 0), a3, voffA);
            PG8_BAR; PG8_WAIT_L(0); PG8_MMA(1, 0, At, B0); PG8_BAR; PG8_SCHED;
            PG8_STAGE(PG8_SB(1, 1), b3 + hstep, voffB);
            PG8_WAIT_V(6); PG8_BAR; PG8_MMA(1, 1, At, B1); PG8_BAR;
            }
        }
        if constexpr (ALIGN_EPI) { if (wr == 0) PG8_BAR; }
        if constexpr (!Epi::AFTER_DRAIN) { E(acc, cur, wr, wc, fr, fq); S.done(cur); }
        if (!has_next) break;
#pragma unroll
        for (int a = 0; a < 2; ++a)
#pragma unroll
            for (int b = 0; b < 2; ++b)
#pragma unroll
                for (int m = 0; m < 4; ++m)
#pragma unroll
                    for (int n = 0; n < 2; ++n) acc[a][b][m][n] = (f32x4){0.f, 0.f, 0.f, 0.f};
        cur = nxt; cA = nA; cB = nB; ++ui;
        if constexpr (ALIGN_EPI) { if (wr == 1) PG8_BAR; }
    }
    PG8_WAIT_V(0);
    if constexpr (!ALIGN_EPI) { if (wr == 0) PG8_BAR; }
    PG8_BAR;
    if constexpr (Epi::AFTER_DRAIN) { E.fused(acc, cur, wr, wc, fr, fq, lds, wid, lane); S.done(cur); }
#undef PG8_SA
#undef PG8_SB
#undef PG8_STAGE
#undef PG8_LDA
#undef PG8_LDB
#undef PG8_MMA
#undef PG8_WAIT_V
#undef PG8_WAIT_L
#undef PG8_BAR
#undef PG8_SCHED
}
}
#define GAS __attribute__((address_space(1)))
#define LAS __attribute__((address_space(3)))
typedef GAS unsigned gu32;
typedef GAS unsigned long long gu64;
#define RLX_AGENT __ATOMIC_RELAXED, __HIP_MEMORY_SCOPE_AGENT
#define LDS_WAIT() asm volatile("s_waitcnt lgkmcnt(0)" ::: "memory")
#define VM_WAIT() asm volatile("s_waitcnt vmcnt(0)" ::: "memory")
#define XB_TMO      128
#define XB_XCNT(j)  (256  + 64 * (j))
#define XB_XSUB(j)  (1280 + 64 * (j))
#define XB_XGEN(j)  (2304 + 64 * (j))
#define XB_TOP      3328
#define XB_TOPGEN   3392
#define XCD_BAR_WORDS 3456
#define XB_SPIN_CAP (1u << 18)

__device__ __forceinline__ unsigned xb_ld(unsigned* p)              { return __hip_atomic_load(p, __ATOMIC_RELAXED, __HIP_MEMORY_SCOPE_AGENT); }
__device__ __forceinline__ unsigned xb_add(unsigned* p, unsigned v) { return __hip_atomic_fetch_add(p, v, __ATOMIC_RELAXED, __HIP_MEMORY_SCOPE_AGENT); }
__device__ __forceinline__ unsigned xb_xcc_id() { return (unsigned)__builtin_amdgcn_s_getreg((3 << 11) | 20) & 0xFu; }
#define XB_SPIN(cond, bar) do { unsigned _sp = 0; while (cond) { __builtin_amdgcn_s_sleep(1); \
    if ((++_sp & 255u) == 0u) { if (xb_ld(&(bar)[XB_TMO])) break; if (_sp > XB_SPIN_CAP) { atomicAdd(&(bar)[XB_TMO], 1u); break; } } } } while (0)

struct XcdBarrier {
    unsigned* bar; unsigned x;
    volatile LAS unsigned* st;
};

__device__ __forceinline__ XcdBarrier xcd_barrier_post(unsigned* bar, volatile LAS unsigned* st) {
    XcdBarrier b; b.bar = bar; b.x = xb_xcc_id(); b.st = st;
    if (threadIdx.x == 0) (void)xb_add(&bar[XB_XCNT(b.x)], 1u);
    return b;
}
__device__ __forceinline__ void xcd_barrier_complete(unsigned* bar, unsigned x, unsigned& nloc, unsigned& nx) {
    const unsigned G = gridDim.x * gridDim.y * gridDim.z;
    unsigned sum, cnt, mine, sp = 0u;
    for (;;) {
        sum = 0u; cnt = 0u; mine = 0u;
#pragma unroll
        for (unsigned j = 0; j < 16; ++j) { const unsigned c = xb_ld(&bar[XB_XCNT(j)]); sum += c; cnt += (c > 0u) ? 1u : 0u; mine = (j == x) ? c : mine; }
        if (sum == G) break;
        __builtin_amdgcn_s_sleep(1);
        if ((++sp & 255u) == 0u) { if (xb_ld(&bar[XB_TMO])) break; if (sp > XB_SPIN_CAP) { atomicAdd(&bar[XB_TMO], 1u); break; } }
    }
    nloc = mine > 0u ? mine : 1u; nx = cnt > 0u ? cnt : 1u;
}

__device__ __forceinline__ void xcd_barrier(const XcdBarrier& b) {
    asm volatile("s_waitcnt vmcnt(0)" ::: "memory");
    __syncthreads();
    if (threadIdx.x == 0) {
        unsigned* bar = b.bar;
        __builtin_amdgcn_s_waitcnt(0);
        unsigned nloc = b.st[0], nx = b.st[1];
        if (nloc == 0u) { xcd_barrier_complete(bar, b.x, nloc, nx); b.st[0] = nloc; b.st[1] = nx; }
        const unsigned old = xb_add(&bar[XB_XSUB(b.x)], 1u);
        const unsigned gen = old / nloc;
        if (old + 1u == (gen + 1u) * nloc) {
            __builtin_amdgcn_fence(__ATOMIC_RELEASE, "agent");
            asm volatile("s_waitcnt vmcnt(0)" ::: "memory");
            const unsigned og = xb_add(&bar[XB_TOP], 1u);
            const unsigned tg = og / nx;
            if (og + 1u == (tg + 1u) * nx) xb_add(&bar[XB_TOPGEN], 1u);
            else XB_SPIN(xb_ld(&bar[XB_TOPGEN]) == tg, bar);
            __builtin_amdgcn_fence(__ATOMIC_ACQUIRE, "agent");
            xb_add(&bar[XB_XGEN(b.x)], 1u);
            asm volatile("s_waitcnt vmcnt(0)" ::: "memory");
        } else {
            XB_SPIN(xb_ld(&bar[XB_XGEN(b.x)]) == gen, bar);
            __builtin_amdgcn_fence(__ATOMIC_ACQUIRE, "agent");
            asm volatile("s_waitcnt vmcnt(0)" ::: "memory");
        }
    }
    __syncthreads();
}

struct Args { const float* in[16]; float* out; unsigned char* ws; };

struct Frame {
    LAS unsigned char* lds;
    int tid, lane, wave, G, bid;
};

__device__ __forceinline__ float wave_sum(float v) {
#pragma unroll
    for (int o = 1; o < 64; o <<= 1) v += __shfl_xor(v, o);
    return v;
}
__device__ __forceinline__ float silu_f(float x) { return x / (1.f + __expf(-x)); }
__device__ __forceinline__ float gelu_tanh_f(float x) { const float y = 0.7978845608028654f * (x + 0.044715f * x * x * x); return 0.5f * x * (1.f + tanhf(y)); }
__device__ __forceinline__ void ld8(const f16_t* p, float (&o)[8]) { const h8 v = *(const h8*)p;
#pragma unroll
    for (int j = 0; j < 8; ++j) o[j] = (float)v[j]; }

__device__ __forceinline__ void transpose_item(const float* W, int K, int ldw, f16_t* WT, int k0, int dr0, int sc0, int valid, LAS float* scr, int lane) {
    const bool ok = (lane & 31) < valid;
#pragma unroll 8
    for (int i = 0; i < 32; ++i) { const int kk = 2 * i + (lane >> 5); scr[kk * 33 + (lane & 31)] = ok ? W[(size_t)(k0 + kk) * ldw + sc0 + (lane & 31)] : 0.f; }
    LDS_WAIT(); asm volatile("" ::: "memory");
    const int c = lane & 7;
#pragma unroll
    for (int j = 0; j < 4; ++j) { const int n = (lane >> 3) + 8 * j; const LAS float* s = scr + (8 * c) * 33 + n;
        uint4 o; o.x = pk_f16(s[0 * 33], s[1 * 33]); o.y = pk_f16(s[2 * 33], s[3 * 33]); o.z = pk_f16(s[4 * 33], s[5 * 33]); o.w = pk_f16(s[6 * 33], s[7 * 33]);
        *(uint4*)(WT + (size_t)(dr0 + n) * K + k0 + 8 * c) = o; }
    LDS_WAIT(); asm volatile("" ::: "memory");
}
__device__ __forceinline__ void rms_row_to_f16(const float* xrow, const float* w, f16_t* orow, int lane) {
    const float4* xr = (const float4*)xrow + lane; const float4* wr = (const float4*)w + lane;
    float4 v[4]; float s = 0.f;
#pragma unroll
    for (int j = 0; j < 4; ++j) { v[j] = xr[64 * j]; s += (v[j].x * v[j].x + v[j].y * v[j].y) + (v[j].z * v[j].z + v[j].w * v[j].w); }
    const float r = rsqrtf(wave_sum(s) * (1.f / D_MODEL) + NORM_EPS);
    uint2* o8 = (uint2*)orow + lane;
#pragma unroll
    for (int j = 0; j < 4; ++j) { const float4 ww = wr[64 * j]; uint2 o; o.x = pk_f16(v[j].x * r * ww.x, v[j].y * r * ww.y); o.y = pk_f16(v[j].z * r * ww.z, v[j].w * r * ww.w); o8[64 * j] = o; }
}
__device__ __forceinline__ void p0_prologue(const Frame& F, const Args& a) {
    LAS float* scr = (LAS float*)(F.lds + RING_OFF + F.wave * 16384);
    const int gw = F.bid * NWAVES + F.wave, NGW = F.G * NWAVES;
    constexpr int I_IN = 16 * (IN_PAD / 32), I_OUT = 16 * 32, I_UP = 16 * (2 * D_FF / 32), I_DOWN = (D_FF / 64) * 32, I_L = I_IN + I_OUT + I_UP + I_DOWN;
    for (int it = gw; it < DEPTH * I_L; it += NGW) {
        const int l = it / I_L; int r = it % I_L;
        unsigned char* wb = a.ws + WS_W + (size_t)l * W_LAYER;
        if (r < I_IN) { const int kb = r / (IN_PAD / 32), nb = r % (IN_PAD / 32); int valid = IN_WIDTH - 32 * nb; valid = valid < 0 ? 0 : (valid > 32 ? 32 : valid);
            transpose_item(a.in[2] + (size_t)l * D_MODEL * IN_WIDTH, D_MODEL, IN_WIDTH, (f16_t*)(wb + W_IN), 64 * kb, 32 * nb, 32 * nb, valid, scr, F.lane); continue; }
        r -= I_IN;
        if (r < I_OUT) { const int kb = r / 32, nb = r % 32;
            transpose_item(a.in[8] + (size_t)l * D_MODEL * D_MODEL, D_MODEL, D_MODEL, (f16_t*)(wb + W_OUT), 64 * kb, 32 * nb, 32 * nb, 32, scr, F.lane); continue; }
        r -= I_OUT;
        if (r < I_UP) { const int kb = r / (2 * D_FF / 32), nb = r % (2 * D_FF / 32); const int r0 = 32 * nb, tj = r0 >> 8, half = (r0 >> 7) & 1, i0 = r0 & 127;
            transpose_item(a.in[11] + (size_t)l * D_MODEL * 2 * D_FF, D_MODEL, 2 * D_FF, (f16_t*)(wb + W_UP), 64 * kb, r0, half * D_FF + 128 * tj + i0, 32, scr, F.lane); continue; }
        r -= I_UP;
        { const int kb = r / 32, nb = r % 32;
            transpose_item(a.in[14] + (size_t)l * D_FF * D_MODEL, D_FF, D_MODEL, (f16_t*)(wb + W_DOWN), 64 * kb, 32 * nb, 32 * nb, 32, scr, F.lane); }
    }
    f16_t* XN = (f16_t*)(a.ws + WS_XN);
    for (int m = gw; m < T_TOK; m += NGW) rms_row_to_f16(a.in[0] + (size_t)m * D_MODEL, a.in[1], XN + (size_t)m * D_MODEL, F.lane);
}

__device__ __forceinline__ void naive_swa(const Frame& F, const f16_t* proj, const float* sinks, f16_t* mixed) {
    for (int idx = F.bid * NTHREADS + F.tid; idx < T_TOK * 4; idx += F.G * NTHREADS) {
        const int t = idx % SEQ, hq = (idx / SEQ) & 3, b = idx / (SEQ * 4), hkv = hq >> 1;
        const float slope = exp2f(-(float)(2 * hq + 1));
        const size_t rb = (size_t)b * SEQ;
        float q[64], o[64];
#pragma unroll
        for (int i = 0; i < 8; ++i) { float v[8]; ld8(proj + (rb + t) * PROJ_W + COL_QA + hq * 64 + 8 * i, v);
#pragma unroll
            for (int j = 0; j < 8; ++j) q[8 * i + j] = v[j] * 0.125f; }
#pragma unroll
        for (int i = 0; i < 64; ++i) o[i] = 0.f;
        float mx = sinks[hq], l = 1.f;
        const int s0 = t - 127 < 0 ? 0 : t - 127;
        for (int s = s0; s <= t; ++s) {
            const f16_t* kp = proj + (rb + s) * PROJ_W + COL_KA + hkv * 64;
            float d = 0.f;
#pragma unroll
            for (int i = 0; i < 8; ++i) { float v[8]; ld8(kp + 8 * i, v);
#pragma unroll
                for (int j = 0; j < 8; ++j) d = fmaf(q[8 * i + j], v[j], d); }
            const float sc = d - slope * (float)(t - s);
            const float mn = fmaxf(mx, sc), f = __expf(mx - mn), p = __expf(sc - mn);
            mx = mn; l = l * f + p;
            const f16_t* vp = proj + (rb + s) * PROJ_W + COL_VA + hkv * 64;
#pragma unroll
            for (int i = 0; i < 8; ++i) { float v[8]; ld8(vp + 8 * i, v);
#pragma unroll
                for (int j = 0; j < 8; ++j) o[8 * i + j] = fmaf(p, v[j], o[8 * i + j] * f); }
        }
        const float rl = 1.f / l;
        uint4* op = (uint4*)(mixed + (rb + t) * D_MODEL + hq * 64);
#pragma unroll
        for (int i = 0; i < 8; ++i) { uint4 w; w.x = pk_f16(o[8 * i] * rl, o[8 * i + 1] * rl); w.y = pk_f16(o[8 * i + 2] * rl, o[8 * i + 3] * rl); w.z = pk_f16(o[8 * i + 4] * rl, o[8 * i + 5] * rl); w.w = pk_f16(o[8 * i + 6] * rl, o[8 * i + 7] * rl); op[i] = w; }
    }
}
__device__ __forceinline__ void moba_block(const f16_t* projb, int h, int t, int blk, int kend, const float (&q)[64], float slope, float& mx, float& l, float (&o)[64]) {
    for (int i = 0; i < kend; ++i) {
        const int s = blk * 256 + i;
        const f16_t* kp = projb + (size_t)s * PROJ_W + COL_KB + h * 64;
        float d = 0.f;
#pragma unroll
        for (int c = 0; c < 8; ++c) { float v[8]; ld8(kp + 8 * c, v);
#pragma unroll
            for (int j = 0; j < 8; ++j) d = fmaf(q[8 * c + j], v[j], d); }
        const float sc = d * 0.125f - slope * (float)(t - s);
        const float mn = fmaxf(mx, sc), f = __expf(mx - mn), p = __expf(sc - mn);
        mx = mn; l = l * f + p;
        const f16_t* vp = projb + (size_t)s * PROJ_W + COL_VB + h * 64;
#pragma unroll
        for (int c = 0; c < 8; ++c) { float v[8]; ld8(vp + 8 * c, v);
#pragma unroll
            for (int j = 0; j < 8; ++j) o[8 * c + j] = fmaf(p, v[j], o[8 * c + j] * f); }
    }
}
__device__ __forceinline__ void naive_moba(const Frame& F, const f16_t* proj, const float* kmean, f16_t* mixed) {
    for (int idx = F.bid * NTHREADS + F.tid; idx < T_TOK * 4; idx += F.G * NTHREADS) {
        const int t = idx % SEQ, h = (idx / SEQ) & 3, b = idx / (SEQ * 4);
        const float slope = exp2f(-(float)(2 * h + 2));
        const f16_t* projb = proj + (size_t)b * SEQ * PROJ_W;
        float q[64], o[64];
#pragma unroll
        for (int i = 0; i < 8; ++i) { float v[8]; ld8(projb + (size_t)t * PROJ_W + COL_QB + h * 64 + 8 * i, v);
#pragma unroll
            for (int j = 0; j < 8; ++j) q[8 * i + j] = v[j]; }
#pragma unroll
        for (int i = 0; i < 64; ++i) o[i] = 0.f;
        const int own = t >> 8;
        float g0 = -3e38f, g1 = -3e38f, g2 = -3e38f; int i0 = -1, i1 = -1, i2 = -1;
        for (int n = 0; n < own; ++n) {
            const float4* kp = (const float4*)(kmean + (size_t)((b * 4 + h) * 32 + n) * 64);
            float d = 0.f;
#pragma unroll
            for (int j = 0; j < 16; ++j) { const float4 v = kp[j]; d = fmaf(q[4 * j], v.x, d); d = fmaf(q[4 * j + 1], v.y, d); d = fmaf(q[4 * j + 2], v.z, d); d = fmaf(q[4 * j + 3], v.w, d); }
            if (d > g0) { g2 = g1; i2 = i1; g1 = g0; i1 = i0; g0 = d; i0 = n; }
            else if (d > g1) { g2 = g1; i2 = i1; g1 = d; i1 = n; }
            else if (d > g2) { g2 = d; i2 = n; }
        }
        float mx = -1e30f, l = 0.f;
        moba_block(projb, h, t, own, (t & 255) + 1, q, slope, mx, l, o);
        if (i0 >= 0) moba_block(projb, h, t, i0, 256, q, slope, mx, l, o);
        if (i1 >= 0) moba_block(projb, h, t, i1, 256, q, slope, mx, l, o);
        if (i2 >= 0) moba_block(projb, h, t, i2, 256, q, slope, mx, l, o);
        const float rl = 1.f / l;
        uint4* op = (uint4*)(mixed + ((size_t)b * SEQ + t) * D_MODEL + 256 + h * 64);
#pragma unroll
        for (int i = 0; i < 8; ++i) { uint4 w; w.x = pk_f16(o[8 * i] * rl, o[8 * i + 1] * rl); w.y = pk_f16(o[8 * i + 2] * rl, o[8 * i + 3] * rl); w.z = pk_f16(o[8 * i + 4] * rl, o[8 * i + 5] * rl); w.w = pk_f16(o[8 * i + 6] * rl, o[8 * i + 7] * rl); op[i] = w; }
    }
}
__device__ __forceinline__ void naive_dn1(const Frame& F, const f16_t* proj, const float* gates, const float* cw, const float* a_log, const float* dt_bias, f16_t* qkvc, float* beta, float* g) {
    const int gw = F.bid * NWAVES + F.wave, NGW = F.G * NWAVES;
    for (int item = gw; item < T_TOK * 4; item += NGW) {
        const int bt = item >> 2, h = item & 3, t = bt % SEQ;
        float val[3][2];
#pragma unroll
        for (int m = 0; m < 3; ++m) {
            const int c = m * 512 + h * 128 + 2 * F.lane;
            float a0 = 0.f, a1 = 0.f;
#pragma unroll
            for (int i = 0; i < 4; ++i) { const int tt = t - 3 + i;
                if (tt >= 0) { const h2 x = *(const h2*)(proj + (size_t)(bt - 3 + i) * PROJ_W + COL_QKVC + c); const float2 w = *(const float2*)(cw + i * 1536 + c);
                    a0 = fmaf(w.x, (float)x[0], a0); a1 = fmaf(w.y, (float)x[1], a1); } }
            val[m][0] = silu_f(a0); val[m][1] = silu_f(a1);
        }
#pragma unroll
        for (int m = 0; m < 2; ++m) { const float r = rsqrtf(wave_sum(val[m][0] * val[m][0] + val[m][1] * val[m][1]) + NORM_EPS); val[m][0] *= r; val[m][1] *= r; }
#pragma unroll
        for (int m = 0; m < 3; ++m) *(unsigned*)(qkvc + (size_t)bt * 1536 + m * 512 + h * 128 + 2 * F.lane) = pk_f16(val[m][0], val[m][1]);
        if (F.lane == 0) {
            const float bc = gates[(size_t)bt * 8 + h], ac = gates[(size_t)bt * 8 + 4 + h] + dt_bias[h];
            beta[bt * 4 + h] = 1.f / (1.f + expf(-bc));
            const float sp = ac > 20.f ? ac : log1pf(expf(ac));
            g[bt * 4 + h] = -expf(a_log[h]) * sp;
        }
    }
}
__device__ __forceinline__ void naive_dn2(const Frame& F, const f16_t* qkvc, const float* beta, const float* g, f16_t* oc) {
    if (F.bid >= 64) return;
    const int b = F.bid >> 4, h = (F.bid >> 2) & 3, cg = F.bid & 3;
    const int dp = F.tid & 15, e = cg * 32 + (F.tid >> 4);
    float s[8];
#pragma unroll
    for (int i = 0; i < 8; ++i) s[i] = 0.f;
    const size_t r0 = (size_t)b * SEQ;
    const f16_t* qb = qkvc + r0 * 1536 + h * 128 + dp * 8;
    const f16_t* kb = qb + 512;
    const f16_t* vb = qkvc + r0 * 1536 + 1024 + h * 128 + e;
    h8 kn = *(const h8*)kb, qn = *(const h8*)qb; f16_t vn = *vb; float bn = beta[r0 * 4 + h], gn = g[r0 * 4 + h];
    const float qscale = 0.08838834764831845f;
    for (int t = 0; t < SEQ; ++t) {
        const h8 ck = kn, cq = qn; const float cv = h2f(vn), cb = bn, eg = __expf(gn);
        if (t + 1 < SEQ) { const size_t off = (size_t)(t + 1) * 1536; kn = *(const h8*)(kb + off); qn = *(const h8*)(qb + off); vn = vb[off]; bn = beta[(r0 + t + 1) * 4 + h]; gn = g[(r0 + t + 1) * 4 + h]; }
        float ks = 0.f;
#pragma unroll
        for (int i = 0; i < 8; ++i) { s[i] *= eg; ks = fmaf((float)ck[i], s[i], ks); }
        ks += __shfl_xor(ks, 1); ks += __shfl_xor(ks, 2); ks += __shfl_xor(ks, 4); ks += __shfl_xor(ks, 8);
        const float c = cb * (cv - ks);
        float o = 0.f;
#pragma unroll
        for (int i = 0; i < 8; ++i) { s[i] = fmaf((float)ck[i], c, s[i]); o = fmaf((float)cq[i], s[i], o); }
        o += __shfl_xor(o, 1); o += __shfl_xor(o, 2); o += __shfl_xor(o, 4); o += __shfl_xor(o, 8);
        if (dp == 0) oc[(r0 + t) * 512 + h * 128 + e] = f2h(o * qscale);
    }
}
__device__ __forceinline__ void naive_dn3(const Frame& F, const f16_t* oc, const f16_t* proj, const float* nw, f16_t* mixed) {
    const int gw = F.bid * NWAVES + F.wave, NGW = F.G * NWAVES;
    for (int item = gw; item < T_TOK * 4; item += NGW) {
        const int bt = item >> 2, h = item & 3;
        const h2 v = *(const h2*)(oc + (size_t)bt * 512 + h * 128 + 2 * F.lane);
        const float v0 = (float)v[0], v1 = (float)v[1];
        const float r = rsqrtf(wave_sum(v0 * v0 + v1 * v1) * (1.f / 128.f) + NORM_EPS);
        const h2 z = *(const h2*)(proj + (size_t)bt * PROJ_W + COL_Z + h * 128 + 2 * F.lane);
        const float2 w = *(const float2*)(nw + 2 * F.lane);
        *(unsigned*)(mixed + (size_t)bt * D_MODEL + 512 + h * 128 + 2 * F.lane) = pk_f16(v0 * r * w.x * silu_f((float)z[0]), v1 * r * w.y * silu_f((float)z[1]));
    }
}
__device__ __forceinline__ void naive_add_norm(const Frame& F, const float* xin, const float* y, const float* w, float* xout, const float* w2, f16_t* xn) {
    const int gw = F.bid * NWAVES + F.wave, NGW = F.G * NWAVES;
    for (int m = gw; m < T_TOK; m += NGW) {
        const float4* yr = (const float4*)(y + (size_t)m * D_MODEL) + F.lane; const float4* xr = (const float4*)(xin + (size_t)m * D_MODEL) + F.lane; const float4* wr = (const float4*)w + F.lane;
        float4 v[4]; float s = 0.f;
#pragma unroll
        for (int j = 0; j < 4; ++j) { v[j] = yr[64 * j]; s += (v[j].x * v[j].x + v[j].y * v[j].y) + (v[j].z * v[j].z + v[j].w * v[j].w); }
        const float r = rsqrtf(wave_sum(s) * (1.f / D_MODEL) + NORM_EPS);
        float4* orow = (float4*)(xout + (size_t)m * D_MODEL) + F.lane; float s2 = 0.f;
#pragma unroll
        for (int j = 0; j < 4; ++j) { const float4 ww = wr[64 * j], xx = xr[64 * j]; float4 o; o.x = xx.x + v[j].x * r * ww.x; o.y = xx.y + v[j].y * r * ww.y; o.z = xx.z + v[j].z * r * ww.z; o.w = xx.w + v[j].w * r * ww.w;
            orow[64 * j] = o; v[j] = o; s2 += (o.x * o.x + o.y * o.y) + (o.z * o.z + o.w * o.w); }
        if (xn) {
            const float r2 = rsqrtf(wave_sum(s2) * (1.f / D_MODEL) + NORM_EPS);
            const float4* w2r = (const float4*)w2 + F.lane; uint2* o8 = (uint2*)(xn + (size_t)m * D_MODEL) + F.lane;
#pragma unroll
            for (int j = 0; j < 4; ++j) { const float4 ww = w2r[64 * j]; uint2 o; o.x = pk_f16(v[j].x * r2 * ww.x, v[j].y * r2 * ww.y); o.y = pk_f16(v[j].z * r2 * ww.z, v[j].w * r2 * ww.w); o8[64 * j] = o; }
        }
    }
}
__device__ __forceinline__ void naive_conv_glu(const Frame& F, const f16_t* ub, const float* cw, const float* cb, f16_t* actb) {
    for (int idx = F.bid * NTHREADS + F.tid; idx < SEQ * 704; idx += F.G * NTHREADS) {
        const int t = idx / 704, j = (idx % 704) * 4, uc = (j >> 7) * 256 + (j & 127);
        float ga[4], ua[4];
        { const float4 a = *(const float4*)(cb + j), c = *(const float4*)(cb + D_FF + j); ga[0] = a.x; ga[1] = a.y; ga[2] = a.z; ga[3] = a.w; ua[0] = c.x; ua[1] = c.y; ua[2] = c.z; ua[3] = c.w; }
#pragma unroll
        for (int i = 0; i < 3; ++i) { const int tt = t - 2 + i;
            if (tt >= 0) { const h4 xg = *(const h4*)(ub + (size_t)tt * (2 * D_FF) + uc), xu = *(const h4*)(ub + (size_t)tt * (2 * D_FF) + uc + 128);
                const float4 wg = *(const float4*)(cw + i * (2 * D_FF) + j), wu = *(const float4*)(cw + i * (2 * D_FF) + D_FF + j);
                ga[0] = fmaf(wg.x, (float)xg[0], ga[0]); ga[1] = fmaf(wg.y, (float)xg[1], ga[1]); ga[2] = fmaf(wg.z, (float)xg[2], ga[2]); ga[3] = fmaf(wg.w, (float)xg[3], ga[3]);
                ua[0] = fmaf(wu.x, (float)xu[0], ua[0]); ua[1] = fmaf(wu.y, (float)xu[1], ua[1]); ua[2] = fmaf(wu.z, (float)xu[2], ua[2]); ua[3] = fmaf(wu.w, (float)xu[3], ua[3]); } }
        uint2 o; o.x = pk_f16(gelu_tanh_f(ga[0]) * ua[0], gelu_tanh_f(ga[1]) * ua[1]); o.y = pk_f16(gelu_tanh_f(ga[2]) * ua[2], gelu_tanh_f(ga[3]) * ua[3]);
        *(uint2*)(actb + (size_t)t * D_FF + j) = o;
    }
}

constexpr int DNI_CHUNK = 73728, DNI_NEGW = 0, DNI_QD = 16384, DNI_KDT = 32768, DNI_A = 49152, DNI_UT = 57344, DNI_STAGE = 57344;
constexpr size_t WS_EGL = 2 * MiB + 512 * 1024;
__device__ __forceinline__ int perm64(int j) { const int rem = j & 31; return (j & ~31) + 8 * ((rem >> 2) & 3) + 4 * (rem >> 4) + (rem & 3); }
__device__ __forceinline__ int imgW_b(int i, int dp) { return i * 256 + ((((dp >> 3) ^ (i & 15))) << 4) + (dp & 7) * 2; }
__device__ __forceinline__ int imgK_b(int row, int cp) { return (row >> 1) * 256 + (((((row & 1) << 3) | (cp >> 3)) ^ ((row >> 1) & 7)) << 4) + (cp & 7) * 2; }
typedef float f32x4 __attribute__((ext_vector_type(4)));
typedef unsigned u32x4v __attribute__((ext_vector_type(4)));
typedef unsigned u32x2v __attribute__((ext_vector_type(2)));

constexpr int PREP_HALF_LDS = 69632, PREP_ROWB = 272;
static_assert(2 * PREP_HALF_LDS <= LDSCTL_OFF, "prep LDS");
__device__ __forceinline__ void dn_prep(const Frame& F, const f16_t* proj, const float* gates, const float* cw, const float* a_log, const float* dt_bias, unsigned char* dni, float* egl) {
    const int half = F.tid >> 8, th0 = F.tid & 255;
    LAS unsigned char* base = F.lds + half * PREP_HALF_LDS;
    LAS unsigned char* Qh = base; LAS unsigned char* Kh = base + 17408; LAS unsigned char* Vh = base + 34816;
    LAS float* Lm = (LAS float*)(base + 52224); LAS float* sbeta = (LAS float*)(base + 68608); LAS float* sG = sbeta + 64; LAS float* seG = sbeta + 128;
    for (int pass = F.bid; pass < 1024; pass += F.G) {
        int th = th0; asm volatile("" : "+v"(th));
        const int lane = th & 63, fr = lane & 15, fq = lane >> 4, wq = th >> 6;
        const int item = 2 * pass + half, bc = item >> 2, h = item & 3, b = bc >> 7, c = bc & 127, t0 = c * 64;
        const size_t row0 = (size_t)b * SEQ + t0;
        unsigned char* out = dni + (size_t)((b * 4 + h) * 128 + c) * DNI_CHUNK;
#pragma unroll 1
        for (int j = 0; j < 12; ++j) {
            const int m = j >> 2, i = (th >> 4) + 16 * (j & 3), cg = th & 15, cc = m * 512 + h * 128 + 8 * cg;
            float acc[8];
#pragma unroll
            for (int e = 0; e < 8; ++e) acc[e] = 0.f;
#pragma unroll
            for (int tap = 0; tap < 4; ++tap) {
                if (t0 + i - 3 + tap >= 0) {
                    float x[8]; ld8(proj + (row0 + i - 3 + tap) * PROJ_W + COL_QKVC + cc, x);
                    const float4 w0 = *(const float4*)(cw + tap * 1536 + cc), w1 = *(const float4*)(cw + tap * 1536 + cc + 4);
                    acc[0] = fmaf(w0.x, x[0], acc[0]); acc[1] = fmaf(w0.y, x[1], acc[1]); acc[2] = fmaf(w0.z, x[2], acc[2]); acc[3] = fmaf(w0.w, x[3], acc[3]);
                    acc[4] = fmaf(w1.x, x[4], acc[4]); acc[5] = fmaf(w1.y, x[5], acc[5]); acc[6] = fmaf(w1.z, x[6], acc[6]); acc[7] = fmaf(w1.w, x[7], acc[7]);
                }
            }
            float ss = 0.f;
#pragma unroll
            for (int e = 0; e < 8; ++e) { acc[e] = silu_f(acc[e]); ss = fmaf(acc[e], acc[e], ss); }
            ss += __shfl_xor(ss, 1); ss += __shfl_xor(ss, 2); ss += __shfl_xor(ss, 4); ss += __shfl_xor(ss, 8);
            float r = 1.f;
            if (m == 0) r = rsqrtf(ss + NORM_EPS) * 0.08838834764831845f; else if (m == 1) r = rsqrtf(ss + NORM_EPS);
            u32x4v o; o.x = pk_f16(acc[0] * r, acc[1] * r); o.y = pk_f16(acc[2] * r, acc[3] * r); o.z = pk_f16(acc[4] * r, acc[5] * r); o.w = pk_f16(acc[6] * r, acc[7] * r);
            *(LAS u32x4v*)(base + m * 17408 + i * PREP_ROWB + cg * 16) = o;
        }
        if (th < 64) {
            const size_t bt = row0 + th;
            const float bcv = gates[bt * 8 + h], ac = gates[bt * 8 + 4 + h] + dt_bias[h];
            const float be = 1.f / (1.f + expf(-bcv));
            const float sp = ac > 20.f ? ac : log1pf(expf(ac));
            float gs = -expf(a_log[h]) * sp;
#pragma unroll
            for (int o = 1; o < 64; o <<= 1) { const float up = __shfl_up(gs, o); if (lane >= o) gs += up; }
            sbeta[th] = be; sG[th] = gs; seG[th] = expf(gs);
        }
        __syncthreads();
        {
            const int mt = wq;
            h8 Ak[4], Aq[4];
#pragma unroll
            for (int s = 0; s < 4; ++s) { Ak[s] = *(const LAS h8*)(Kh + (16 * mt + fr) * PREP_ROWB + (32 * s + 8 * fq) * 2); Aq[s] = *(const LAS h8*)(Qh + (16 * mt + fr) * PREP_ROWB + (32 * s + 8 * fq) * 2); }
#pragma unroll
            for (int nt = 0; nt < 4; ++nt) {
                f32x4 kk = {0.f, 0.f, 0.f, 0.f}, qk = {0.f, 0.f, 0.f, 0.f};
#pragma unroll
                for (int s = 0; s < 4; ++s) { const h8 Bk = *(const LAS h8*)(Kh + (16 * nt + fr) * PREP_ROWB + (32 * s + 8 * fq) * 2);
                    kk = __builtin_amdgcn_mfma_f32_16x16x32_f16(Ak[s], Bk, kk, 0, 0, 0); qk = __builtin_amdgcn_mfma_f32_16x16x32_f16(Aq[s], Bk, qk, 0, 0, 0); }
                const int jc = 16 * nt + fr; const float Gj = sG[jc];
#pragma unroll
                for (int r = 0; r < 4; ++r) { const int i = 16 * mt + 4 * fq + r; const float dec = __expf(sG[i] - Gj);
                    Lm[i * 64 + jc] = (jc < i) ? sbeta[i] * kk[r] * dec : 0.f;
                    *(f16_t*)(out + DNI_A + imgK_b(i, perm64(jc))) = f2h((jc <= i) ? qk[r] * dec : 0.f); }
            }
        }
        __syncthreads();
        {
            float x[64];
            const bool isU = th < 128; const int cidx = th & 127;
            const LAS unsigned char* src = (isU ? Vh : Kh) + cidx * 2;
#pragma unroll
            for (int i = 0; i < 64; ++i) {
                const float eGi = seG[i]; const float rv = h2f(*(const LAS f16_t*)(src + i * PREP_ROWB)) * sbeta[i] * (isU ? 1.f : eGi);
                float a0 = rv, a1 = 0.f, a2 = 0.f, a3 = 0.f;
#pragma unroll
                for (int j4 = 0; j4 < (i + 3) / 4; ++j4) { const f32x4 lv = *(const LAS f32x4*)(Lm + i * 64 + 4 * j4);
                    if (4 * j4 + 0 < i) a0 = fmaf(-lv.x, x[4 * j4 + 0], a0); if (4 * j4 + 1 < i) a1 = fmaf(-lv.y, x[4 * j4 + 1], a1);
                    if (4 * j4 + 2 < i) a2 = fmaf(-lv.z, x[4 * j4 + 2], a2); if (4 * j4 + 3 < i) a3 = fmaf(-lv.w, x[4 * j4 + 3], a3); }
                x[i] = (a0 + a1) + (a2 + a3);
                asm volatile("" ::: "memory");
            }
            if (isU) {
                u32x4v* up = (u32x4v*)(out + DNI_UT + cidx * 128);
#pragma unroll
                for (int q8 = 0; q8 < 8; ++q8) { u32x4v o; o.x = pk_f16(x[8 * q8], x[8 * q8 + 1]); o.y = pk_f16(x[8 * q8 + 2], x[8 * q8 + 3]); o.z = pk_f16(x[8 * q8 + 4], x[8 * q8 + 5]); o.w = pk_f16(x[8 * q8 + 6], x[8 * q8 + 7]); up[q8] = o; }
            } else {
                const int dp = perm64(cidx);
#pragma unroll
                for (int i = 0; i < 64; ++i) *(f16_t*)(out + DNI_NEGW + imgW_b(i, dp)) = f2h(-x[i]);
            }
        }
#pragma unroll
        for (int j = 0; j < 4; ++j) {
            const int i = (th >> 4) + 16 * j, cg = th & 15; const float sc = seG[i];
            const h8 qv = *(const LAS h8*)(Qh + i * PREP_ROWB + cg * 16);
            const int s32 = (cg >> 2) * 32, jh = (cg & 3) >> 1;
            u32x2v lo, hi; lo.x = pk_f16((float)qv[0] * sc, (float)qv[1] * sc); lo.y = pk_f16((float)qv[2] * sc, (float)qv[3] * sc); hi.x = pk_f16((float)qv[4] * sc, (float)qv[5] * sc); hi.y = pk_f16((float)qv[6] * sc, (float)qv[7] * sc);
            *(u32x2v*)(out + DNI_QD + imgW_b(i, s32 + 8 * (2 * (cg & 1)) + 4 * jh)) = lo;
            *(u32x2v*)(out + DNI_QD + imgW_b(i, s32 + 8 * (2 * (cg & 1) + 1) + 4 * jh)) = hi;
        }
        {
            const int d = th & 127, ih = th >> 7; const float Gl = sG[63];
            float kv[32];
#pragma unroll
            for (int rem = 0; rem < 32; ++rem) { const int i = 32 * ih + rem; kv[8 * ((rem >> 2) & 3) + 4 * (rem >> 4) + (rem & 3)] = h2f(*(const LAS f16_t*)(Kh + i * PREP_ROWB + d * 2)) * __expf(Gl - sG[i]); }
#pragma unroll
            for (int q8 = 0; q8 < 4; ++q8) { u32x4v o; o.x = pk_f16(kv[8 * q8], kv[8 * q8 + 1]); o.y = pk_f16(kv[8 * q8 + 2], kv[8 * q8 + 3]); o.z = pk_f16(kv[8 * q8 + 4], kv[8 * q8 + 5]); o.w = pk_f16(kv[8 * q8 + 6], kv[8 * q8 + 7]);
                *(u32x4v*)(out + DNI_KDT + imgK_b(d, 32 * ih + 8 * q8)) = o; }
            if (th == 0) egl[(b * 4 + h) * 128 + c] = seG[63];
        }
        __syncthreads();
    }
}

constexpr int SCAN_PART_OFF = 2 * DNI_STAGE;
__device__ __forceinline__ void dn_scan(const Frame& F, const unsigned char* dni, const float* egl, const f16_t* proj, const float* nw, f16_t* mixed) {
    if (F.bid >= 16) return;
    const int bh = F.bid, b = bh >> 2, h = bh & 3, wv = F.wave, lane = F.lane, fr = lane & 15, fq = lane >> 4, tid = F.tid;
    const unsigned char* src = dni + (size_t)(bh * 128) * DNI_CHUNK;
    LAS unsigned char* lds = F.lds;
    f32x4 S[8];
#pragma unroll
    for (int m = 0; m < 8; ++m) S[m] = (f32x4){0.f, 0.f, 0.f, 0.f};
    u32x4v st[7]; u32x2v un[4]; f16_t zn[16]; float egn;
    const f16_t* zbase = proj + (size_t)b * SEQ * PROJ_W + COL_Z + h * 128 + 16 * wv + fr;
    const float nwe = nw[16 * wv + fr];
#define DN_LOAD(cc) do { const unsigned char* s_ = src + (size_t)(cc) * DNI_CHUNK; \
        _Pragma("unroll") for (int k = 0; k < 7; ++k) st[k] = *(const u32x4v*)(s_ + tid * 16 + 8192 * k); \
        _Pragma("unroll") for (int mt = 0; mt < 4; ++mt) un[mt] = *(const u32x2v*)(s_ + DNI_UT + (16 * wv + fr) * 128 + (16 * mt + 4 * fq) * 2); \
        _Pragma("unroll") for (int mt = 0; mt < 4; ++mt) _Pragma("unroll") for (int r = 0; r < 4; ++r) zn[4 * mt + r] = zbase[(size_t)((cc) * 64 + 16 * mt + 4 * fq + r) * PROJ_W]; \
        egn = egl[bh * 128 + (cc)]; } while (0)
    DN_LOAD(0);
#pragma unroll
    for (int k = 0; k < 7; ++k) *(LAS u32x4v*)(lds + tid * 16 + 8192 * k) = st[k];
    __syncthreads();
    f32x4 op[4]; f16_t zp[16];
#pragma unroll
    for (int mt = 0; mt < 4; ++mt) op[mt] = (f32x4){0.f, 0.f, 0.f, 0.f};
#pragma unroll
    for (int i = 0; i < 16; ++i) zp[i] = 0;
#pragma unroll 1
    for (int c = 0; c < 128; ++c) {
        LAS unsigned char* cur = lds + (c & 1) * DNI_STAGE; LAS unsigned char* nxt = lds + ((c + 1) & 1) * DNI_STAGE;
        f32x4 vn[4]; f16_t zc[16]; const float eg = egn;
#pragma unroll
        for (int mt = 0; mt < 4; ++mt) { const h4 uu = __builtin_bit_cast(h4, un[mt]); vn[mt] = (f32x4){(float)uu[0], (float)uu[1], (float)uu[2], (float)uu[3]}; }
#pragma unroll
        for (int i = 0; i < 16; ++i) zc[i] = zn[i];
        if (c + 1 < 128) DN_LOAD(c + 1);
        if (c > 0) {
            const LAS float* part = (const LAS float*)(lds + SCAN_PART_OFF + ((c - 1) & 1) * 2048);
#pragma unroll
            for (int mt = 0; mt < 4; ++mt)
#pragma unroll
                for (int r = 0; r < 4; ++r) { const int i = 16 * mt + 4 * fq + r; const f32x4 p0 = *(const LAS f32x4*)(part + i * 8), p1 = *(const LAS f32x4*)(part + i * 8 + 4);
                    const float ss = ((p0.x + p0.y) + (p0.z + p0.w)) + ((p1.x + p1.y) + (p1.z + p1.w)); const float rn = rsqrtf(ss * (1.f / 128.f) + NORM_EPS);
                    mixed[((size_t)b * SEQ + (c - 1) * 64 + i) * D_MODEL + 512 + h * 128 + 16 * wv + fr] = f2h(op[mt][r] * rn * nwe * silu_f(h2f(zp[4 * mt + r]))); }
        }
        h8 Sb[4];
#pragma unroll
        for (int s = 0; s < 4; ++s) Sb[s] = (h8){(_Float16)S[2 * s][0], (_Float16)S[2 * s][1], (_Float16)S[2 * s][2], (_Float16)S[2 * s][3], (_Float16)S[2 * s + 1][0], (_Float16)S[2 * s + 1][1], (_Float16)S[2 * s + 1][2], (_Float16)S[2 * s + 1][3]};
        f32x4 o[4];
#pragma unroll
        for (int mt = 0; mt < 4; ++mt) { const int row = 16 * mt + fr; o[mt] = (f32x4){0.f, 0.f, 0.f, 0.f};
#pragma unroll
            for (int s = 0; s < 4; ++s) { const int off = row * 256 + (((4 * s + fq) ^ (row & 15)) << 4);
                const h8 aw = *(const LAS h8*)(cur + DNI_NEGW + off), aq = *(const LAS h8*)(cur + DNI_QD + off);
                vn[mt] = __builtin_amdgcn_mfma_f32_16x16x32_f16(aw, Sb[s], vn[mt], 0, 0, 0); o[mt] = __builtin_amdgcn_mfma_f32_16x16x32_f16(aq, Sb[s], o[mt], 0, 0, 0); } }
        h8 Vb[2];
#pragma unroll
        for (int s = 0; s < 2; ++s) Vb[s] = (h8){(_Float16)vn[2 * s][0], (_Float16)vn[2 * s][1], (_Float16)vn[2 * s][2], (_Float16)vn[2 * s][3], (_Float16)vn[2 * s + 1][0], (_Float16)vn[2 * s + 1][1], (_Float16)vn[2 * s + 1][2], (_Float16)vn[2 * s + 1][3]};
#pragma unroll
        for (int mt = 0; mt < 4; ++mt) { const int row = 16 * mt + fr;
#pragma unroll
            for (int s = 0; s < 2; ++s) { const int off = (row >> 1) * 256 + (((((row & 1) << 3) | (4 * s + fq)) ^ ((row >> 1) & 7)) << 4);
                o[mt] = __builtin_amdgcn_mfma_f32_16x16x32_f16(*(const LAS h8*)(cur + DNI_A + off), Vb[s], o[mt], 0, 0, 0); } }
#pragma unroll
        for (int m = 0; m < 8; ++m) { const int row = 16 * m + fr; S[m] = S[m] * eg;
#pragma unroll
            for (int s = 0; s < 2; ++s) { const int off = (row >> 1) * 256 + (((((row & 1) << 3) | (4 * s + fq)) ^ ((row >> 1) & 7)) << 4);
                S[m] = __builtin_amdgcn_mfma_f32_16x16x32_f16(*(const LAS h8*)(cur + DNI_KDT + off), Vb[s], S[m], 0, 0, 0); } }
        {
            LAS float* part = (LAS float*)(lds + SCAN_PART_OFF + (c & 1) * 2048);
#pragma unroll
            for (int mt = 0; mt < 4; ++mt)
#pragma unroll
                for (int r = 0; r < 4; ++r) { float ss = o[mt][r] * o[mt][r]; ss += __shfl_xor(ss, 1); ss += __shfl_xor(ss, 2); ss += __shfl_xor(ss, 4); ss += __shfl_xor(ss, 8);
                    if (fr == 0) part[(16 * mt + 4 * fq + r) * 8 + wv] = ss; }
        }
        if (c + 1 < 128) {
#pragma unroll
            for (int k = 0; k < 7; ++k) *(LAS u32x4v*)(nxt + tid * 16 + 8192 * k) = st[k];
        }
#pragma unroll
        for (int mt = 0; mt < 4; ++mt) op[mt] = o[mt];
#pragma unroll
        for (int i = 0; i < 16; ++i) zp[i] = zc[i];
        __syncthreads();
    }
    {
        const LAS float* part = (const LAS float*)(lds + SCAN_PART_OFF + (127 & 1) * 2048);
#pragma unroll
        for (int mt = 0; mt < 4; ++mt)
#pragma unroll
            for (int r = 0; r < 4; ++r) { const int i = 16 * mt + 4 * fq + r; const f32x4 p0 = *(const LAS f32x4*)(part + i * 8), p1 = *(const LAS f32x4*)(part + i * 8 + 4);
                const float ss = ((p0.x + p0.y) + (p0.z + p0.w)) + ((p1.x + p1.y) + (p1.z + p1.w)); const float rn = rsqrtf(ss * (1.f / 128.f) + NORM_EPS);
                mixed[((size_t)b * SEQ + 127 * 64 + i) * D_MODEL + 512 + h * 128 + 16 * wv + fr] = f2h(op[mt][r] * rn * nwe * silu_f(h2f(zp[4 * mt + r]))); }
    }
#undef DN_LOAD
    __syncthreads();
}

__global__ void __launch_bounds__(NTHREADS, 2) fwd_kernel(Args args) {
    extern __shared__ __attribute__((aligned(16))) unsigned char lds[];
    Frame F;
    F.lds = (LAS unsigned char*)lds;
    F.tid = threadIdx.x; F.lane = F.tid & 63; F.wave = __builtin_amdgcn_readfirstlane(F.tid >> 6);
    F.G = gridDim.x; F.bid = blockIdx.x;
    gu32* ctl0 = (gu32*)(args.ws + WS_CTL);
    for (int u = F.tid; u < (LDS_BYTES - LDSCTL_OFF) / 4; u += NTHREADS) ((LAS unsigned*)(F.lds + LDSCTL_OFF))[u] = 0u;
    __syncthreads();
    XcdBarrier bar = xcd_barrier_post((unsigned*)(ctl0 + CW_BAR), (volatile LAS unsigned*)(F.lds + MISC_OFF) + 8);
#define GRID_BAR() do { XcdBarrier b_ = bar; asm volatile("" : "+s"(b_.x), "+s"(b_.bar)); xcd_barrier(b_); } while (0)

    p0_prologue(F, args);
    GRID_BAR();
    constexpr int PH_PER_LAYER = 16, NPH = DEPTH * PH_PER_LAYER;
    for (int ph = 0; ph < NPH; ++ph) {
        int p = ph; asm volatile("" : "+s"(p));
        { int t_ = threadIdx.x; asm volatile("" : "+v"(t_)); F.tid = t_; F.lane = t_ & 63; F.wave = __builtin_amdgcn_readfirstlane(t_ >> 6); }
        { int b_ = blockIdx.x, g_ = gridDim.x; asm volatile("" : "+s"(b_), "+s"(g_)); F.bid = b_; F.G = g_; }
        unsigned char* ws = args.ws; asm volatile("" : "+s"(ws));
        gu32* ctl = (gu32*)(ws + WS_CTL);
        f16_t* XN = (f16_t*)(ws + WS_XN); f16_t* PROJ = (f16_t*)(ws + WS_PROJ); f16_t* MIXED = (f16_t*)(ws + WS_MIXED); f16_t* ACT = (f16_t*)(ws + WS_ACT);
        float* GATES = (float*)(ws + WS_GATES); float* BETA = (float*)(ws + WS_BG); float* GG = BETA + (size_t)T_TOK * 4;
        f16_t* QKVC = (f16_t*)(ws + WS_QKVC); f16_t* OC = (f16_t*)(ws + WS_OC); float* Y1 = (float*)(ws + WS_Y1); float* Y2 = (float*)(ws + WS_Y2); f16_t* UB = (f16_t*)(ws + WS_UB);
        const int l = p / PH_PER_LAYER, k = p % PH_PER_LAYER;
        unsigned char* wb = ws + WS_W + (size_t)l * W_LAYER;
        float* kmean = (float*)(ctl + CW_KMEAN) + (size_t)l * 32768;
        if (k == 0) {
            pg8::Gemm g{XN, (const f16_t*)(wb + W_IN), T_TOK, IN_PAD, D_MODEL}; pg8::StaticOrder S; S.init(T_TOK, IN_PAD, F.G, F.bid);
            pg8::EpiProj E{PROJ, GATES, kmean};
            pg8::gemm_phase<pg8::EpiProj, pg8::StaticOrder, true, true>(F.lds + RING_OFF, g, S, E);
        } else if (k == 1) {
            dn_prep(F, PROJ, GATES, args.in[4] + (size_t)l * 4 * 1536, args.in[5] + l * 4, args.in[6] + l * 4, ws + WS_DNI, (float*)(ws + WS_EGL));
            naive_swa(F, PROJ, args.in[3] + l * 4, MIXED);
            naive_moba(F, PROJ, kmean, MIXED);
        } else if (k == 2) {
            dn_scan(F, ws + WS_DNI, (const float*)(ws + WS_EGL), PROJ, args.in[7] + l * 128, MIXED);
        } else if (k == 4) {
            pg8::Gemm g{MIXED, (const f16_t*)(wb + W_OUT), T_TOK, D_MODEL, D_MODEL}; pg8::StaticOrder S; S.init(T_TOK, D_MODEL, F.G, F.bid);
            pg8::EpiF32 E{Y1, D_MODEL};
            pg8::gemm_phase<pg8::EpiF32, pg8::StaticOrder, true, true>(F.lds + RING_OFF, g, S, E);
        } else if (k == 5) {
            naive_add_norm(F, l == 0 ? args.in[0] : args.out, Y1, args.in[9] + l * D_MODEL, args.out, args.in[10] + l * D_MODEL, XN);
        } else if (k < 14) {
            const int b = (k - 6) >> 1;
            if (((k - 6) & 1) == 0) {
                pg8::Gemm g{XN + (size_t)b * SEQ * D_MODEL, (const f16_t*)(wb + W_UP), SEQ, 2 * D_FF, D_MODEL}; pg8::StaticOrder S; S.init(SEQ, 2 * D_FF, F.G, F.bid);
                pg8::EpiF16 E{UB, 2 * D_FF};
                pg8::gemm_phase<pg8::EpiF16, pg8::StaticOrder, true, true>(F.lds + RING_OFF, g, S, E);
            } else {
                naive_conv_glu(F, UB, args.in[12] + (size_t)l * 3 * 2 * D_FF, args.in[13] + (size_t)l * 2 * D_FF, ACT + (size_t)b * SEQ * D_FF);
            }
        } else if (k == 14) {
            pg8::Gemm g{ACT, (const f16_t*)(wb + W_DOWN), T_TOK, D_MODEL, D_FF}; pg8::StaticOrder S; S.init(T_TOK, D_MODEL, F.G, F.bid);
            pg8::EpiF32 E{Y2, D_MODEL};
            pg8::gemm_phase<pg8::EpiF32, pg8::StaticOrder, true, true>(F.lds + RING_OFF, g, S, E);
        } else {
            naive_add_norm(F, args.out, Y2, args.in[15] + l * D_MODEL, args.out, l + 1 < DEPTH ? args.in[1] + (l + 1) * D_MODEL : nullptr, l + 1 < DEPTH ? XN : nullptr);
        }
        if (ph + 1 < NPH) GRID_BAR();
    }
}

extern "C" void kernel_launch(void* const* d_in, const int* in_sizes, int n_in, void* d_out, int out_size, void* d_ws, size_t ws_size, hipStream_t stream) {
    static int grid = 0;
    if (grid == 0) {
        if (n_in != 16 || ws_size < WS_END) { fprintf(stderr, "kernel_launch: unexpected n_in %d or ws_size %zu (< %zu)\n", n_in, ws_size, (size_t)WS_END); grid = -1; return; }
        int dev = 0, cus = 0, per_cu = 0;
        if (hipGetDevice(&dev) != hipSuccess || hipDeviceGetAttribute(&cus, hipDeviceAttributeMultiprocessorCount, dev) != hipSuccess) { grid = -1; return; }
        if (hipFuncSetAttribute((const void*)fwd_kernel, hipFuncAttributeMaxDynamicSharedMemorySize, LDS_BYTES) != hipSuccess) { fprintf(stderr, "kernel_launch: hipFuncSetAttribute failed\n"); grid = -1; return; }
        if (hipOccupancyMaxActiveBlocksPerMultiprocessor(&per_cu, (const void*)fwd_kernel, NTHREADS, LDS_BYTES) != hipSuccess || per_cu < 1) { fprintf(stderr, "kernel_launch: occupancy query failed (%d)\n", per_cu); (void)hipGetLastError(); per_cu = 1; }
        grid = cus * 1;
        if (per_cu < 1) grid = -1;
    }
    if (grid < 0) return;
    if (hipMemsetAsync((char*)d_ws + WS_CTL, 0, CTL_ZERO_BYTES, stream) != hipSuccess) return;
    Args a{};
    for (int i = 0; i < 16; ++i) a.in[i] = (const float*)d_in[i];
    a.out = (float*)d_out; a.ws = (unsigned char*)d_ws;
    hipLaunchKernelGGL(fwd_kernel, dim3(grid), dim3(NTHREADS), LDS_BYTES, stream, a);
}
```

```cpp
#include <hip/hip_runtime.h>
#include <cstdio>
#include <cstdint>

constexpr int D_MODEL = 1024, BATCH = 4, SEQ = 8192, DEPTH = 2, T_TOK = BATCH * SEQ;
constexpr int IN_WIDTH = 3336, IN_PAD = 3584, PROJ_W = 3328, D_FF = 2816;
constexpr int COL_QA = 0, COL_KA = 256, COL_VA = 384, COL_QB = 512, COL_KB = 768, COL_VB = 1024, COL_QKVC = 1280, COL_Z = 2816;
constexpr float NORM_EPS = 1e-6f;
constexpr int NWAVES = 8, NTHREADS = 512;

constexpr size_t MiB = 1u << 20;
constexpr size_t WS_CTL = 0, CTL_ZERO_BYTES = 1 * MiB;
constexpr size_t WS_GATES = 1 * MiB;
constexpr size_t WS_SEL = 2 * MiB;
constexpr size_t WS_BG = 3 * MiB;
constexpr size_t WS_W = 4 * MiB, W_LAYER = 26 * MiB;
constexpr size_t W_IN = 0, W_OUT = 7 * MiB, W_UP = 9 * MiB, W_DOWN = 20 * MiB;
constexpr size_t WS_XN = 56 * MiB;
constexpr size_t WS_DNI = 56 * MiB;
constexpr size_t WS_PROJ = 200 * MiB;
constexpr size_t WS_ACT = 200 * MiB;
constexpr size_t WS_MIXED = 408 * MiB;
constexpr size_t WS_SPARE = 472 * MiB;
constexpr size_t WS_END = 512 * MiB;
constexpr size_t WS_QKVC = 56 * MiB;
constexpr size_t WS_OC = WS_SPARE;
constexpr size_t WS_Y1 = WS_PROJ;
constexpr size_t WS_Y2 = 376 * MiB;
constexpr size_t WS_UB = 408 * MiB;
constexpr int CW_BAR = 4096;
constexpr int CW_QCTR = 8192;
constexpr int CW_KMEAN = 131072;
static_assert((CW_KMEAN + 2 * 32768) * 4 <= (int)CTL_ZERO_BYTES, "ctl");

constexpr int RING_OFF = 0, RING_BYTES = 131072;
constexpr int LDS_BYTES = 163840;
constexpr int LDSCTL_OFF = LDS_BYTES - 1024, MISC_OFF = LDSCTL_OFF + 320;

typedef unsigned short f16_t;
typedef _Float16 h8 __attribute__((ext_vector_type(8)));
typedef _Float16 h4 __attribute__((ext_vector_type(4)));
typedef _Float16 h2 __attribute__((ext_vector_type(2)));
__device__ __forceinline__ unsigned pk_f16(float lo, float hi) { h2 v = {(_Float16)lo, (_Float16)hi}; return __builtin_bit_cast(unsigned, v); }
__device__ __forceinline__ float h2f(f16_t b) { return (float)__builtin_bit_cast(_Float16, b); }
__device__ __forceinline__ f16_t f2h(float f) { return __builtin_bit_cast(f16_t, (_Float16)f); }

namespace pg8 {
#define PG8_LAS __attribute__((address_space(3)))
typedef unsigned short bf16_t;
typedef _Float16 bf16x8 __attribute__((ext_vector_type(8)));
typedef float f32x4 __attribute__((ext_vector_type(4)));
typedef unsigned u32x4 __attribute__((ext_vector_type(4)));
constexpr int BM = 256, BK = 64, HALF = 128, HTB = HALF * BK * 2  , STAGE_BYTES = 8 * HTB, NXCD = 8, WGM = 8;

__host__ __device__ __forceinline__ int lds_byte(int r, int c) { const int st = (r >> 4) * 2 + (c >> 5), rr = r & 15, cc = c & 31, ob = rr * 64 + cc * 2; return st * 1024 + (ob ^ (((ob >> 9) & 1) << 5)); }
__host__ __device__ __forceinline__ void stage_rc(int b, int& R, int& C) { const int st = b / 1024, sb = b % 1024, swz = sb ^ (((sb >> 9) & 1) << 5); R = (st >> 1) * 16 + swz / 64; C = (st & 1) * 32 + (swz % 64) / 2; }
__host__ __device__ __forceinline__ int perm32(int rho) { const int n = rho >> 4, i = rho & 15; return 8 * (i >> 2) + 4 * n + (i & 3); }

struct Unit { int pm, pn; };
struct Gemm { const bf16_t* A; const bf16_t* Bt; int M, N, K; };

struct StaticOrder {
    int nM, nN, nwg, G, c;
    __host__ __device__ void init(int M, int N, int G_, int c_) { nM = M / BM; nN = N / BM; nwg = nM * nN; G = G_; c = c_; }
    __host__ __device__ bool next(int i, Unit& u) const {
        const long L = (long)i * G + c; if (L >= nwg) return false;
        int wgid = (int)L; { const int q = nwg / NXCD, r = nwg % NXCD, xcd = wgid % NXCD, off = wgid / NXCD; wgid = (xcd < r ? xcd * (q + 1) : r * (q + 1) + (xcd - r) * q) + off; }
        const int nig = WGM * nN, gid = wgid / nig, fm = gid * WGM, gsz = (nM - fm) < WGM ? (nM - fm) : WGM;
        u.pm = fm + ((wgid % nig) % gsz); u.pn = (wgid % nig) / gsz; return true;
    }
    __device__ __forceinline__ void a_ready(const Unit&) const {}
    __device__ __forceinline__ void done(const Unit&) const {}
};

struct EpiF32 {
    static constexpr bool PERM = false, AFTER_DRAIN = false;
    float* C; int ldc;
    __device__ __forceinline__ void operator()(const f32x4 (&acc)[2][2][4][2], const Unit& u, int wr, int wc, int fr, int fq) const {
        const int row0 = u.pm * BM + wr * 64 + fr, col0 = u.pn * BM + wc * 32 + 4 * fq;
#pragma unroll
        for (int ai = 0; ai < 2; ++ai)
#pragma unroll
            for (int m = 0; m < 4; ++m) { float* rowp = C + (size_t)(row0 + ai * HALF + m * 16) * ldc + col0;
#pragma unroll
                for (int bj = 0; bj < 2; ++bj)
#pragma unroll
                    for (int n = 0; n < 2; ++n) *(f32x4*)(rowp + bj * HALF + n * 16) = acc[ai][bj][m][n]; }
    }
};
struct EpiF16 {
    static constexpr bool PERM = true, AFTER_DRAIN = false;
    bf16_t* O; int ldc;
    __device__ __forceinline__ void operator()(const f32x4 (&acc)[2][2][4][2], const Unit& u, int wr, int wc, int fr, int fq) const {
        const int row0 = u.pm * BM + wr * 64 + fr, col0 = u.pn * BM + wc * 32 + 8 * fq;
#pragma unroll
        for (int ai = 0; ai < 2; ++ai)
#pragma unroll
            for (int m = 0; m < 4; ++m) { bf16_t* rowp = O + (size_t)(row0 + ai * HALF + m * 16) * ldc + col0;
#pragma unroll
                for (int bj = 0; bj < 2; ++bj) { const f32x4 v0 = acc[ai][bj][m][0], v1 = acc[ai][bj][m][1];
                    u32x4 w; w.x = pk_f16(v0[0], v0[1]); w.y = pk_f16(v0[2], v0[3]); w.z = pk_f16(v1[0], v1[1]); w.w = pk_f16(v1[2], v1[3]);
                    *(u32x4*)(rowp + bj * HALF) = w; } }
    }
};
struct EpiProj {
    static constexpr bool PERM = true, AFTER_DRAIN = false;
    bf16_t* P; float* gates; float* kmean;
    __device__ __forceinline__ void operator()(const f32x4 (&acc)[2][2][4][2], const Unit& u, int wr, int wc, int fr, int fq) const {
        const int row0 = u.pm * BM + wr * 64 + fr;
        if (u.pn < 13) {
            const int col0 = u.pn * BM + wc * 32 + 8 * fq;
#pragma unroll
            for (int ai = 0; ai < 2; ++ai)
#pragma unroll
                for (int m = 0; m < 4; ++m) { bf16_t* rowp = P + (size_t)(row0 + ai * HALF + m * 16) * PROJ_W + col0;
#pragma unroll
                    for (int bj = 0; bj < 2; ++bj) { const f32x4 v0 = acc[ai][bj][m][0], v1 = acc[ai][bj][m][1];
                        u32x4 w; w.x = pk_f16(v0[0], v0[1]); w.y = pk_f16(v0[2], v0[3]); w.z = pk_f16(v1[0], v1[1]); w.w = pk_f16(v1[2], v1[3]);
                        *(u32x4*)(rowp + bj * HALF) = w; } }
            if (u.pn == 3) {
                const int b = u.pm >> 5, nb = u.pm & 31;
#pragma unroll
                for (int bj = 0; bj < 2; ++bj)
#pragma unroll
                    for (int n = 0; n < 2; ++n) {
                        f32x4 s = {0.f, 0.f, 0.f, 0.f};
#pragma unroll
                        for (int ai = 0; ai < 2; ++ai)
#pragma unroll
                            for (int m = 0; m < 4; ++m) s += acc[ai][bj][m][n];
#pragma unroll
                        for (int j = 0; j < 4; ++j) { float v = s[j]; v += __shfl_xor(v, 1); v += __shfl_xor(v, 2); v += __shfl_xor(v, 4); v += __shfl_xor(v, 8); s[j] = v; }
                        if (fr == 0) { const int c = 128 * bj + 32 * wc + 8 * fq + 4 * n, h = c >> 6, d = c & 63; float* kp = kmean + (size_t)((b * 4 + h) * 32 + nb) * 64 + d;
#pragma unroll
                            for (int j = 0; j < 4; ++j) atomicAdd(kp + j, s[j] * (1.0f / 256.0f)); }
                    }
            }
        } else if (wc == 0 && fq == 0) {
#pragma unroll
            for (int ai = 0; ai < 2; ++ai)
#pragma unroll
                for (int m = 0; m < 4; ++m) { float* gp = gates + (size_t)(row0 + ai * HALF + m * 16) * 8;
                    *(f32x4*)gp = acc[ai][0][m][0]; *(f32x4*)(gp + 4) = acc[ai][0][m][1]; }
        }
    }
};

template <class Epi, class Sched, bool ALIGN_EPI = false, bool SP2 = false>
__device__ __forceinline__ void gemm_phase(PG8_LAS unsigned char* lds, const Gemm g, const Sched& S, const Epi& E, int tid_in) {
    int tid_ = tid_in; asm volatile("" : "+v"(tid_));
    const int tid = tid_, wid = __builtin_amdgcn_readfirstlane(tid >> 6), lane = tid & 63, wr = wid >> 2, wc = wid & 3, fr = lane & 15, fq = lane >> 4;
    const int K = g.K, nt = K / BK;
    unsigned voffA[2], voffB[2];
#pragma unroll
    for (int i = 0; i < 2; ++i) { int R, C; stage_rc(tid * 16 + i * 8192, R, C); const int Rb = Epi::PERM ? ((R & ~31) + perm32(R & 31)) : R;
        voffA[i] = (unsigned)(R * K + C) * 2u; voffB[i] = (unsigned)(Rb * K + C) * 2u; }
    const size_t kstep = (size_t)(BK * 2);
    const size_t hstep = (size_t)HALF * K * 2;
    const size_t tstep = 2 * hstep;
    const unsigned ldsw = (unsigned)wid * 1024u;
    const int aoff = lds_byte(wr * 64 + fr, fq * 8), boff = lds_byte(wc * 32 + fr, fq * 8);
#define PG8_SA(b, h) (((b) * 2 + (h)) * HTB)
#define PG8_SB(b, h) ((4 + (b) * 2 + (h)) * HTB)
#define PG8_STAGE(bufoff, gbase, voff) do { _Pragma("unroll") for (int _i = 0; _i < 2; ++_i) \
        __builtin_amdgcn_global_load_lds((const unsigned*)((const char*)(gbase) + (voff)[_i]), (PG8_LAS unsigned*)(lds + (bufoff) + ldsw + _i * 8192), 16, 0, 0); } while (0)
#define PG8_LDA(dst, b, h) do { _Pragma("unroll") for (int m = 0; m < 4; ++m) _Pragma("unroll") for (int k = 0; k < 2; ++k) dst[m][k] = *(const PG8_LAS bf16x8*)(lds + PG8_SA(b, h) + aoff + m * 2048 + k * 1024); } while (0)
#define PG8_LDB(dst, b, h) do { _Pragma("unroll") for (int n = 0; n < 2; ++n) _Pragma("unroll") for (int k = 0; k < 2; ++k) dst[n][k] = *(const PG8_LAS bf16x8*)(lds + PG8_SB(b, h) + boff + n * 2048 + k * 1024); } while (0)
#define PG8_MMA(ai, bj, At, Bt) do { __builtin_amdgcn_s_setprio(1); _Pragma("unroll") for (int m = 0; m < 4; ++m) _Pragma("unroll") for (int n = 0; n < 2; ++n) _Pragma("unroll") for (int k = 0; k < 2; ++k) \
        acc[ai][bj][m][n] = __builtin_amdgcn_mfma_f32_16x16x32_f16(Bt[n][k], At[m][k], acc[ai][bj][m][n], 0, 0, 0); __builtin_amdgcn_s_setprio(0); } while (0)
#define PG8_WAIT_V(n) asm volatile("s_waitcnt vmcnt(" #n ")" ::: "memory")
#define PG8_WAIT_L(n) asm volatile("s_waitcnt lgkmcnt(" #n ")" ::: "memory")
#define PG8_BAR __builtin_amdgcn_s_barrier()
#define PG8_SCHED __builtin_amdgcn_sched_barrier(0)
    Unit cur, nxt; int ui = 0;
    if (!S.next(0, cur)) return;
    f32x4 acc[2][2][4][2];
#pragma unroll
    for (int a = 0; a < 2; ++a)
#pragma unroll
        for (int b = 0; b < 2; ++b)
#pragma unroll
            for (int m = 0; m < 4; ++m)
#pragma unroll
                for (int n = 0; n < 2; ++n) acc[a][b][m][n] = (f32x4){0.f, 0.f, 0.f, 0.f};
    bf16x8 At[4][2], B0[2][2], B1[2][2];
    const char* cA = (const char*)g.A + (size_t)cur.pm * tstep; const char* cB = (const char*)g.Bt + (size_t)cur.pn * tstep;
    S.a_ready(cur);
    if constexpr (SP2) {
        PG8_STAGE(PG8_SB(0, 0), cB, voffB); PG8_STAGE(PG8_SB(0, 1), cB + hstep, voffB); PG8_STAGE(PG8_SA(0, 0), cA, voffA); PG8_STAGE(PG8_SA(0, 1), cA + hstep, voffA);
        if (wr == 1) PG8_BAR;
        PG8_WAIT_V(2); PG8_BAR;
        PG8_STAGE(PG8_SB(1, 0), cB + kstep, voffB); PG8_STAGE(PG8_SA(1, 0), cA + kstep, voffA); PG8_STAGE(PG8_SB(1, 1), cB + hstep + kstep, voffB);
        PG8_WAIT_V(6); PG8_BAR;
    } else {
        PG8_STAGE(PG8_SB(0, 0), cB, voffB); PG8_STAGE(PG8_SA(0, 0), cA, voffA); PG8_STAGE(PG8_SB(0, 1), cB + hstep, voffB); PG8_STAGE(PG8_SA(0, 1), cA + hstep, voffA);
        if (wr == 1) PG8_BAR;
        PG8_WAIT_V(4); PG8_BAR;
        PG8_STAGE(PG8_SB(1, 0), cB + kstep, voffB); PG8_STAGE(PG8_SA(1, 0), cA + kstep, voffA); PG8_STAGE(PG8_SB(1, 1), cB + hstep + kstep, voffB);
        PG8_WAIT_V(6); PG8_BAR;
    }
    for (;;) {
        const bool has_next = S.next(ui + 1, nxt);
        const char* nA = has_next ? (const char*)g.A + (size_t)nxt.pm * tstep : cA; const char* nB = has_next ? (const char*)g.Bt + (size_t)nxt.pn * tstep : cB;
        for (int t = 0; t < nt; t += 2) {
            const bool last = (t == nt - 2);
            const char* a1 = cA + (size_t)(t + 1) * kstep;
            const char* a2 = last ? nA : cA + (size_t)(t + 2) * kstep; const char* b2 = last ? nB : cB + (size_t)(t + 2) * kstep;
            const char* a3 = a2 + kstep; const char* b3 = b2 + kstep;
            if (last && has_next) S.a_ready(nxt);
            if constexpr (SP2) {
            PG8_LDB(B0, 0, 0); PG8_LDB(B1, 0, 1); PG8_SCHED; PG8_LDA(At, 0, 0); PG8_STAGE(PG8_SA(1, 1), a1 + hstep, voffA);
            PG8_WAIT_V(8); PG8_WAIT_L(0); PG8_BAR; PG8_MMA(0, 0, At, B0); PG8_MMA(0, 1, At, B1); PG8_BAR; PG8_SCHED;
            PG8_LDA(At, 0, 1); PG8_STAGE(PG8_SB(0, 0), b2, voffB); PG8_STAGE(PG8_SB(0, 1), b2 + hstep, voffB); PG8_STAGE(PG8_SA(0, 0), a2, voffA);
            PG8_WAIT_V(8); PG8_WAIT_L(0); PG8_BAR; PG8_MMA(1, 0, At, B0); PG8_MMA(1, 1, At, B1); PG8_BAR; PG8_SCHED;
            PG8_LDB(B0, 1, 0); PG8_LDB(B1, 1, 1); PG8_SCHED; PG8_LDA(At, 1, 0); PG8_STAGE(PG8_SA(0, 1), a2 + hstep, voffA);
            PG8_WAIT_V(8); PG8_WAIT_L(0); PG8_BAR; PG8_MMA(0, 0, At, B0); PG8_MMA(0, 1, At, B1); PG8_BAR; PG8_SCHED;
            PG8_LDA(At, 1, 1); PG8_STAGE(PG8_SB(1, 0), b3, voffB); PG8_STAGE(PG8_SB(1, 1), b3 + hstep, voffB); PG8_STAGE(PG8_SA(1, 0), a3, voffA);
            PG8_WAIT_V(8); PG8_WAIT_L(0); PG8_BAR; PG8_MMA(1, 0, At, B0); PG8_MMA(1, 1, At, B1); PG8_BAR; PG8_SCHED;
            } else {
            PG8_LDB(B0, 0, 0); PG8_SCHED; PG8_LDA(At, 0, 0); PG8_STAGE(PG8_SA(1, 1), a1 + hstep, voffA);
            PG8_WAIT_L(8); PG8_BAR; PG8_WAIT_L(0); PG8_MMA(0, 0, At, B0); PG8_BAR; PG8_SCHED;
            PG8_LDB(B1, 0, 1); PG8_STAGE(PG8_SB(0, 0), b2, voffB);
            PG8_BAR; PG8_WAIT_L(0); PG8_MMA(0, 1, At, B1); PG8_BAR;
            PG8_LDA(At, 0, 1); PG8_STAGE(PG8_SA(0, 0), a2, voffA);
            PG8_BAR; PG8_WAIT_L(0); PG8_MMA(1, 0, At, B0); PG8_BAR; PG8_SCHED;
            PG8_STAGE(PG8_SB(0, 1), b2 + hstep, voffB);
            PG8_WAIT_V(6); PG8_BAR; PG8_MMA(1, 1, At, B1); PG8_BAR;
            PG8_LDB(B0, 1, 0); PG8_SCHED; PG8_LDA(At, 1, 0); PG8_STAGE(PG8_SA(0, 1), a2 + hstep, voffA);
            PG8_WAIT_L(8); PG8_BAR; PG8_WAIT_L(0); PG8_MMA(0, 0, At, B0); PG8_BAR; PG8_SCHED;
            PG8_LDB(B1, 1, 1); PG8_STAGE(PG8_SB(1, 0), b3, voffB);
            PG8_BAR; PG8_WAIT_L(0); PG8_MMA(0, 1, At, B1); PG8_BAR;
            PG8_LDA(At, 1, 1); PG8_STAGE(PG8_SA(1, 0), a3, voffA);
            PG8_BAR; PG8_WAIT_L(0); PG8_MMA(1, 0, At, B0); PG8_BAR; PG8_SCHED;
            PG8_STAGE(PG8_SB(1, 1), b3 + hstep, voffB);
            PG8_WAIT_V(6); PG8_BAR; PG8_MMA(1, 1, At, B1); PG8_BAR;
            }
        }
        if constexpr (ALIGN_EPI) { if (wr == 0) PG8_BAR; }
        if constexpr (!Epi::AFTER_DRAIN) { E(acc, cur, wr, wc, fr, fq); S.done(cur); }
        if (!has_next) break;
#pragma unroll
        for (int a = 0; a < 2; ++a)
#pragma unroll
            for (int b = 0; b < 2; ++b)
#pragma unroll
                for (int m = 0; m < 4; ++m)
#pragma unroll
                    for (int n = 0; n < 2; ++n) acc[a][b][m][n] = (f32x4){0.f, 0.f, 0.f, 0.f};
        cur = nxt; cA = nA; cB = nB; ++ui;
        if constexpr (ALIGN_EPI) { if (wr == 1) PG8_BAR; }
    }
    PG8_WAIT_V(0);
    if constexpr (!ALIGN_EPI) { if (wr == 0) PG8_BAR; }
    PG8_BAR;
    if constexpr (Epi::AFTER_DRAIN) { E.fused(acc, cur, wr, wc, fr, fq, lds, wid, lane); S.done(cur); }
#undef PG8_SA
#undef PG8_SB
#undef PG8_STAGE
#undef PG8_LDA
#undef PG8_LDB
#undef PG8_MMA
#undef PG8_WAIT_V
#undef PG8_WAIT_L
#undef PG8_BAR
#undef PG8_SCHED
}
}
#define GAS __attribute__((address_space(1)))
#define LAS __attribute__((address_space(3)))
typedef GAS unsigned gu32;
typedef GAS unsigned long long gu64;
#define RLX_AGENT __ATOMIC_RELAXED, __HIP_MEMORY_SCOPE_AGENT
#define LDS_WAIT() asm volatile("s_waitcnt lgkmcnt(0)" ::: "memory")
#define VM_WAIT() asm volatile("s_waitcnt vmcnt(0)" ::: "memory")
#define XB_TMO      128
#define XB_XCNT(j)  (256  + 64 * (j))
#define XB_XSUB(j)  (1280 + 64 * (j))
#define XB_XGEN(j)  (2304 + 64 * (j))
#define XB_TOP      3328
#define XB_TOPGEN   3392
#define XCD_BAR_WORDS 3456
#define XB_SPIN_CAP (1u << 18)

__device__ __forceinline__ unsigned xb_ld(unsigned* p)              { return __hip_atomic_load(p, __ATOMIC_RELAXED, __HIP_MEMORY_SCOPE_AGENT); }
__device__ __forceinline__ unsigned xb_add(unsigned* p, unsigned v) { return __hip_atomic_fetch_add(p, v, __ATOMIC_RELAXED, __HIP_MEMORY_SCOPE_AGENT); }
__device__ __forceinline__ unsigned xb_xcc_id() { return (unsigned)__builtin_amdgcn_s_getreg((3 << 11) | 20) & 0xFu; }
#define XB_SPIN(cond, bar) do { unsigned _sp = 0; while (cond) { __builtin_amdgcn_s_sleep(1); \
    if ((++_sp & 255u) == 0u) { if (xb_ld(&(bar)[XB_TMO])) break; if (_sp > XB_SPIN_CAP) { atomicAdd(&(bar)[XB_TMO], 1u); break; } } } } while (0)

struct XcdBarrier {
    unsigned* bar; unsigned x;
    volatile LAS unsigned* st;
};

__device__ __forceinline__ XcdBarrier xcd_barrier_post(unsigned* bar, volatile LAS unsigned* st) {
    XcdBarrier b; b.bar = bar; b.x = xb_xcc_id(); b.st = st;
    if (threadIdx.x == 0) (void)xb_add(&bar[XB_XCNT(b.x)], 1u);
    return b;
}
__device__ __forceinline__ void xcd_barrier_complete(unsigned* bar, unsigned x, unsigned& nloc, unsigned& nx) {
    const unsigned G = gridDim.x * gridDim.y * gridDim.z;
    unsigned sum, cnt, mine, sp = 0u;
    for (;;) {
        sum = 0u; cnt = 0u; mine = 0u;
#pragma unroll
        for (unsigned j = 0; j < 16; ++j) { const unsigned c = xb_ld(&bar[XB_XCNT(j)]); sum += c; cnt += (c > 0u) ? 1u : 0u; mine = (j == x) ? c : mine; }
        if (sum == G) break;
        __builtin_amdgcn_s_sleep(1);
        if ((++sp & 255u) == 0u) { if (xb_ld(&bar[XB_TMO])) break; if (sp > XB_SPIN_CAP) { atomicAdd(&bar[XB_TMO], 1u); break; } }
    }
    nloc = mine > 0u ? mine : 1u; nx = cnt > 0u ? cnt : 1u;
}

__device__ __forceinline__ void xcd_barrier(const XcdBarrier& b) {
    asm volatile("s_waitcnt vmcnt(0)" ::: "memory");
    __syncthreads();
    if (threadIdx.x == 0) {
        unsigned* bar = b.bar;
        __builtin_amdgcn_s_waitcnt(0);
        unsigned nloc = b.st[0], nx = b.st[1];
        if (nloc == 0u) { xcd_barrier_complete(bar, b.x, nloc, nx); b.st[0] = nloc; b.st[1] = nx; }
        const unsigned old = xb_add(&bar[XB_XSUB(b.x)], 1u);
        const unsigned gen = old / nloc;
        if (old + 1u == (gen + 1u) * nloc) {
            __builtin_amdgcn_fence(__ATOMIC_RELEASE, "agent");
            asm volatile("s_waitcnt vmcnt(0)" ::: "memory");
            const unsigned og = xb_add(&bar[XB_TOP], 1u);
            const unsigned tg = og / nx;
            if (og + 1u == (tg + 1u) * nx) xb_add(&bar[XB_TOPGEN], 1u);
            else XB_SPIN(xb_ld(&bar[XB_TOPGEN]) == tg, bar);
            __builtin_amdgcn_fence(__ATOMIC_ACQUIRE, "agent");
            xb_add(&bar[XB_XGEN(b.x)], 1u);
            asm volatile("s_waitcnt vmcnt(0)" ::: "memory");
        } else {
            XB_SPIN(xb_ld(&bar[XB_XGEN(b.x)]) == gen, bar);
            __builtin_amdgcn_fence(__ATOMIC_ACQUIRE, "agent");
            asm volatile("s_waitcnt vmcnt(0)" ::: "memory");
        }
    }
    __syncthreads();
}

struct Args { const float* in[16]; float* out; unsigned char* ws; };

struct Frame {
    LAS unsigned char* lds;
    int tid, lane, wave, G, bid;
};

__device__ __forceinline__ float wave_sum(float v) {
#pragma unroll
    for (int o = 1; o < 64; o <<= 1) v += __shfl_xor(v, o);
    return v;
}
__device__ __forceinline__ float silu_f(float x) { return x / (1.f + __expf(-x)); }
__device__ __forceinline__ float gelu_tanh_f(float x) { const float y = 0.7978845608028654f * (x + 0.044715f * x * x * x); return 0.5f * x * (1.f + tanhf(y)); }
__device__ __forceinline__ void ld8(const f16_t* p, float (&o)[8]) { const h8 v = *(const h8*)p;
#pragma unroll
    for (int j = 0; j < 8; ++j) o[j] = (float)v[j]; }

__device__ __forceinline__ void transpose_item(const float* W, int K, int ldw, f16_t* WT, int k0, int dr0, int sc0, int valid, LAS float* scr, int lane) {
    const bool ok = (lane & 31) < valid;
#pragma unroll 8
    for (int i = 0; i < 32; ++i) { const int kk = 2 * i + (lane >> 5); scr[kk * 33 + (lane & 31)] = ok ? W[(size_t)(k0 + kk) * ldw + sc0 + (lane & 31)] : 0.f; }
    LDS_WAIT(); asm volatile("" ::: "memory");
    const int c = lane & 7;
#pragma unroll
    for (int j = 0; j < 4; ++j) { const int n = (lane >> 3) + 8 * j; const LAS float* s = scr + (8 * c) * 33 + n;
        uint4 o; o.x = pk_f16(s[0 * 33], s[1 * 33]); o.y = pk_f16(s[2 * 33], s[3 * 33]); o.z = pk_f16(s[4 * 33], s[5 * 33]); o.w = pk_f16(s[6 * 33], s[7 * 33]);
        *(uint4*)(WT + (size_t)(dr0 + n) * K + k0 + 8 * c) = o; }
    LDS_WAIT(); asm volatile("" ::: "memory");
}
__device__ __forceinline__ void rms_row_to_f16(const float* xrow, const float* w, f16_t* orow, int lane) {
    const float4* xr = (const float4*)xrow + lane; const float4* wr = (const float4*)w + lane;
    float4 v[4]; float s = 0.f;
#pragma unroll
    for (int j = 0; j < 4; ++j) { v[j] = xr[64 * j]; s += (v[j].x * v[j].x + v[j].y * v[j].y) + (v[j].z * v[j].z + v[j].w * v[j].w); }
    const float r = rsqrtf(wave_sum(s) * (1.f / D_MODEL) + NORM_EPS);
    uint2* o8 = (uint2*)orow + lane;
#pragma unroll
    for (int j = 0; j < 4; ++j) { const float4 ww = wr[64 * j]; uint2 o; o.x = pk_f16(v[j].x * r * ww.x, v[j].y * r * ww.y); o.y = pk_f16(v[j].z * r * ww.z, v[j].w * r * ww.w); o8[64 * j] = o; }
}
__device__ __forceinline__ void p0_prologue(const Frame& F, const Args& a) {
    LAS float* scr = (LAS float*)(F.lds + RING_OFF + F.wave * 16384);
    const int gw = F.bid * NWAVES + F.wave, NGW = F.G * NWAVES;
    constexpr int I_IN = 16 * (IN_PAD / 32), I_OUT = 16 * 32, I_UP = 16 * (2 * D_FF / 32), I_DOWN = (D_FF / 64) * 32, I_L = I_IN + I_OUT + I_UP + I_DOWN;
    for (int it = gw; it < DEPTH * I_L; it += NGW) {
        const int l = it / I_L; int r = it % I_L;
        unsigned char* wb = a.ws + WS_W + (size_t)l * W_LAYER;
        if (r < I_IN) { const int kb = r / (IN_PAD / 32), nb = r % (IN_PAD / 32); int valid = IN_WIDTH - 32 * nb; valid = valid < 0 ? 0 : (valid > 32 ? 32 : valid);
            transpose_item(a.in[2] + (size_t)l * D_MODEL * IN_WIDTH, D_MODEL, IN_WIDTH, (f16_t*)(wb + W_IN), 64 * kb, 32 * nb, 32 * nb, valid, scr, F.lane); continue; }
        r -= I_IN;
        if (r < I_OUT) { const int kb = r / 32, nb = r % 32;
            transpose_item(a.in[8] + (size_t)l * D_MODEL * D_MODEL, D_MODEL, D_MODEL, (f16_t*)(wb + W_OUT), 64 * kb, 32 * nb, 32 * nb, 32, scr, F.lane); continue; }
        r -= I_OUT;
        if (r < I_UP) { const int kb = r / (2 * D_FF / 32), nb = r % (2 * D_FF / 32); const int r0 = 32 * nb, tj = r0 >> 8, half = (r0 >> 7) & 1, i0 = r0 & 127;
            transpose_item(a.in[11] + (size_t)l * D_MODEL * 2 * D_FF, D_MODEL, 2 * D_FF, (f16_t*)(wb + W_UP), 64 * kb, r0, half * D_FF + 128 * tj + i0, 32, scr, F.lane); continue; }
        r -= I_UP;
        { const int kb = r / 32, nb = r % 32;
            transpose_item(a.in[14] + (size_t)l * D_FF * D_MODEL, D_FF, D_MODEL, (f16_t*)(wb + W_DOWN), 64 * kb, 32 * nb, 32 * nb, 32, scr, F.lane); }
    }
    f16_t* XN = (f16_t*)(a.ws + WS_XN);
    for (int m = gw; m < T_TOK; m += NGW) rms_row_to_f16(a.in[0] + (size_t)m * D_MODEL, a.in[1], XN + (size_t)m * D_MODEL, F.lane);
}

__device__ __forceinline__ void naive_swa(const Frame& F, const f16_t* proj, const float* sinks, f16_t* mixed) {
    for (int idx = F.bid * NTHREADS + F.tid; idx < T_TOK * 4; idx += F.G * NTHREADS) {
        const int t = idx % SEQ, hq = (idx / SEQ) & 3, b = idx / (SEQ * 4), hkv = hq >> 1;
        const float slope = exp2f(-(float)(2 * hq + 1));
        const size_t rb = (size_t)b * SEQ;
        float q[64], o[64];
#pragma unroll
        for (int i = 0; i < 8; ++i) { float v[8]; ld8(proj + (rb + t) * PROJ_W + COL_QA + hq * 64 + 8 * i, v);
#pragma unroll
            for (int j = 0; j < 8; ++j) q[8 * i + j] = v[j] * 0.125f; }
#pragma unroll
        for (int i = 0; i < 64; ++i) o[i] = 0.f;
        float mx = sinks[hq], l = 1.f;
        const int s0 = t - 127 < 0 ? 0 : t - 127;
        for (int s = s0; s <= t; ++s) {
            const f16_t* kp = proj + (rb + s) * PROJ_W + COL_KA + hkv * 64;
            float d = 0.f;
#pragma unroll
            for (int i = 0; i < 8; ++i) { float v[8]; ld8(kp + 8 * i, v);
#pragma unroll
                for (int j = 0; j < 8; ++j) d = fmaf(q[8 * i + j], v[j], d); }
            const float sc = d - slope * (float)(t - s);
            const float mn = fmaxf(mx, sc), f = __expf(mx - mn), p = __expf(sc - mn);
            mx = mn; l = l * f + p;
            const f16_t* vp = proj + (rb + s) * PROJ_W + COL_VA + hkv * 64;
#pragma unroll
            for (int i = 0; i < 8; ++i) { float v[8]; ld8(vp + 8 * i, v);
#pragma unroll
                for (int j = 0; j < 8; ++j) o[8 * i + j] = fmaf(p, v[j], o[8 * i + j] * f); }
        }
        const float rl = 1.f / l;
        uint4* op = (uint4*)(mixed + (rb + t) * D_MODEL + hq * 64);
#pragma unroll
        for (int i = 0; i < 8; ++i) { uint4 w; w.x = pk_f16(o[8 * i] * rl, o[8 * i + 1] * rl); w.y = pk_f16(o[8 * i + 2] * rl, o[8 * i + 3] * rl); w.z = pk_f16(o[8 * i + 4] * rl, o[8 * i + 5] * rl); w.w = pk_f16(o[8 * i + 6] * rl, o[8 * i + 7] * rl); op[i] = w; }
    }
}
__device__ __forceinline__ void moba_block(const f16_t* projb, int h, int t, int blk, int kend, const float (&q)[64], float slope, float& mx, float& l, float (&o)[64]) {
    for (int i = 0; i < kend; ++i) {
        const int s = blk * 256 + i;
        const f16_t* kp = projb + (size_t)s * PROJ_W + COL_KB + h * 64;
        float d = 0.f;
#pragma unroll
        for (int c = 0; c < 8; ++c) { float v[8]; ld8(kp + 8 * c, v);
#pragma unroll
            for (int j = 0; j < 8; ++j) d = fmaf(q[8 * c + j], v[j], d); }
        const float sc = d * 0.125f - slope * (float)(t - s);
        const float mn = fmaxf(mx, sc), f = __expf(mx - mn), p = __expf(sc - mn);
        mx = mn; l = l * f + p;
        const f16_t* vp = projb + (size_t)s * PROJ_W + COL_VB + h * 64;
#pragma unroll
        for (int c = 0; c < 8; ++c) { float v[8]; ld8(vp + 8 * c, v);
#pragma unroll
            for (int j = 0; j < 8; ++j) o[8 * c + j] = fmaf(p, v[j], o[8 * c + j] * f); }
    }
}
__device__ __forceinline__ void naive_moba(const Frame& F, const f16_t* proj, const float* kmean, f16_t* mixed) {
    for (int idx = F.bid * NTHREADS + F.tid; idx < T_TOK * 4; idx += F.G * NTHREADS) {
        const int t = idx % SEQ, h = (idx / SEQ) & 3, b = idx / (SEQ * 4);
        const float slope = exp2f(-(float)(2 * h + 2));
        const f16_t* projb = proj + (size_t)b * SEQ * PROJ_W;
        float q[64], o[64];
#pragma unroll
        for (int i = 0; i < 8; ++i) { float v[8]; ld8(projb + (size_t)t * PROJ_W + COL_QB + h * 64 + 8 * i, v);
#pragma unroll
            for (int j = 0; j < 8; ++j) q[8 * i + j] = v[j]; }
#pragma unroll
        for (int i = 0; i < 64; ++i) o[i] = 0.f;
        const int own = t >> 8;
        float g0 = -3e38f, g1 = -3e38f, g2 = -3e38f; int i0 = -1, i1 = -1, i2 = -1;
        for (int n = 0; n < own; ++n) {
            const float4* kp = (const float4*)(kmean + (size_t)((b * 4 + h) * 32 + n) * 64);
            float d = 0.f;
#pragma unroll
            for (int j = 0; j < 16; ++j) { const float4 v = kp[j]; d = fmaf(q[4 * j], v.x, d); d = fmaf(q[4 * j + 1], v.y, d); d = fmaf(q[4 * j + 2], v.z, d); d = fmaf(q[4 * j + 3], v.w, d); }
            if (d > g0) { g2 = g1; i2 = i1; g1 = g0; i1 = i0; g0 = d; i0 = n; }
            else if (d > g1) { g2 = g1; i2 = i1; g1 = d; i1 = n; }
            else if (d > g2) { g2 = d; i2 = n; }
        }
        float mx = -1e30f, l = 0.f;
        moba_block(projb, h, t, own, (t & 255) + 1, q, slope, mx, l, o);
        if (i0 >= 0) moba_block(projb, h, t, i0, 256, q, slope, mx, l, o);
        if (i1 >= 0) moba_block(projb, h, t, i1, 256, q, slope, mx, l, o);
        if (i2 >= 0) moba_block(projb, h, t, i2, 256, q, slope, mx, l, o);
        const float rl = 1.f / l;
        uint4* op = (uint4*)(mixed + ((size_t)b * SEQ + t) * D_MODEL + 256 + h * 64);
#pragma unroll
        for (int i = 0; i < 8; ++i) { uint4 w; w.x = pk_f16(o[8 * i] * rl, o[8 * i + 1] * rl); w.y = pk_f16(o[8 * i + 2] * rl, o[8 * i + 3] * rl); w.z = pk_f16(o[8 * i + 4] * rl, o[8 * i + 5] * rl); w.w = pk_f16(o[8 * i + 6] * rl, o[8 * i + 7] * rl); op[i] = w; }
    }
}
__device__ __forceinline__ void naive_dn1(const Frame& F, const f16_t* proj, const float* gates, const float* cw, const float* a_log, const float* dt_bias, f16_t* qkvc, float* beta, float* g) {
    const int gw = F.bid * NWAVES + F.wave, NGW = F.G * NWAVES;
    for (int item = gw; item < T_TOK * 4; item += NGW) {
        const int bt = item >> 2, h = item & 3, t = bt % SEQ;
        float val[3][2];
#pragma unroll
        for (int m = 0; m < 3; ++m) {
            const int c = m * 512 + h * 128 + 2 * F.lane;
            float a0 = 0.f, a1 = 0.f;
#pragma unroll
            for (int i = 0; i < 4; ++i) { const int tt = t - 3 + i;
                if (tt >= 0) { const h2 x = *(const h2*)(proj + (size_t)(bt - 3 + i) * PROJ_W + COL_QKVC + c); const float2 w = *(const float2*)(cw + i * 1536 + c);
                    a0 = fmaf(w.x, (float)x[0], a0); a1 = fmaf(w.y, (float)x[1], a1); } }
            val[m][0] = silu_f(a0); val[m][1] = silu_f(a1);
        }
#pragma unroll
        for (int m = 0; m < 2; ++m) { const float r = rsqrtf(wave_sum(val[m][0] * val[m][0] + val[m][1] * val[m][1]) + NORM_EPS); val[m][0] *= r; val[m][1] *= r; }
#pragma unroll
        for (int m = 0; m < 3; ++m) *(unsigned*)(qkvc + (size_t)bt * 1536 + m * 512 + h * 128 + 2 * F.lane) = pk_f16(val[m][0], val[m][1]);
        if (F.lane == 0) {
            const float bc = gates[(size_t)bt * 8 + h], ac = gates[(size_t)bt * 8 + 4 + h] + dt_bias[h];
            beta[bt * 4 + h] = 1.f / (1.f + expf(-bc));
            const float sp = ac > 20.f ? ac : log1pf(expf(ac));
            g[bt * 4 + h] = -expf(a_log[h]) * sp;
        }
    }
}
__device__ __forceinline__ void naive_dn2(const Frame& F, const f16_t* qkvc, const float* beta, const float* g, f16_t* oc) {
    if (F.bid >= 64) return;
    const int b = F.bid >> 4, h = (F.bid >> 2) & 3, cg = F.bid & 3;
    const int dp = F.tid & 15, e = cg * 32 + (F.tid >> 4);
    float s[8];
#pragma unroll
    for (int i = 0; i < 8; ++i) s[i] = 0.f;
    const size_t r0 = (size_t)b * SEQ;
    const f16_t* qb = qkvc + r0 * 1536 + h * 128 + dp * 8;
    const f16_t* kb = qb + 512;
    const f16_t* vb = qkvc + r0 * 1536 + 1024 + h * 128 + e;
    h8 kn = *(const h8*)kb, qn = *(const h8*)qb; f16_t vn = *vb; float bn = beta[r0 * 4 + h], gn = g[r0 * 4 + h];
    const float qscale = 0.08838834764831845f;
    for (int t = 0; t < SEQ; ++t) {
        const h8 ck = kn, cq = qn; const float cv = h2f(vn), cb = bn, eg = __expf(gn);
        if (t + 1 < SEQ) { const size_t off = (size_t)(t + 1) * 1536; kn = *(const h8*)(kb + off); qn = *(const h8*)(qb + off); vn = vb[off]; bn = beta[(r0 + t + 1) * 4 + h]; gn = g[(r0 + t + 1) * 4 + h]; }
        float ks = 0.f;
#pragma unroll
        for (int i = 0; i < 8; ++i) { s[i] *= eg; ks = fmaf((float)ck[i], s[i], ks); }
        ks += __shfl_xor(ks, 1); ks += __shfl_xor(ks, 2); ks += __shfl_xor(ks, 4); ks += __shfl_xor(ks, 8);
        const float c = cb * (cv - ks);
        float o = 0.f;
#pragma unroll
        for (int i = 0; i < 8; ++i) { s[i] = fmaf((float)ck[i], c, s[i]); o = fmaf((float)cq[i], s[i], o); }
        o += __shfl_xor(o, 1); o += __shfl_xor(o, 2); o += __shfl_xor(o, 4); o += __shfl_xor(o, 8);
        if (dp == 0) oc[(r0 + t) * 512 + h * 128 + e] = f2h(o * qscale);
    }
}
__device__ __forceinline__ void naive_dn3(const Frame& F, const f16_t* oc, const f16_t* proj, const float* nw, f16_t* mixed) {
    const int gw = F.bid * NWAVES + F.wave, NGW = F.G * NWAVES;
    for (int item = gw; item < T_TOK * 4; item += NGW) {
        const int bt = item >> 2, h = item & 3;
        const h2 v = *(const h2*)(oc + (size_t)bt * 512 + h * 128 + 2 * F.lane);
        const float v0 = (float)v[0], v1 = (float)v[1];
        const float r = rsqrtf(wave_sum(v0 * v0 + v1 * v1) * (1.f / 128.f) + NORM_EPS);
        const h2 z = *(const h2*)(proj + (size_t)bt * PROJ_W + COL_Z + h * 128 + 2 * F.lane);
        const float2 w = *(const float2*)(nw + 2 * F.lane);
        *(unsigned*)(mixed + (size_t)bt * D_MODEL + 512 + h * 128 + 2 * F.lane) = pk_f16(v0 * r * w.x * silu_f((float)z[0]), v1 * r * w.y * silu_f((float)z[1]));
    }
}
__device__ __forceinline__ void naive_add_norm(const Frame& F, const float* xin, const float* y, const float* w, float* xout, const float* w2, f16_t* xn) {
    const int gw = F.bid * NWAVES + F.wave, NGW = F.G * NWAVES;
    for (int m = gw; m < T_TOK; m += NGW) {
        const float4* yr = (const float4*)(y + (size_t)m * D_MODEL) + F.lane; const float4* xr = (const float4*)(xin + (size_t)m * D_MODEL) + F.lane; const float4* wr = (const float4*)w + F.lane;
        float4 v[4]; float s = 0.f;
#pragma unroll
        for (int j = 0; j < 4; ++j) { v[j] = yr[64 * j]; s += (v[j].x * v[j].x + v[j].y * v[j].y) + (v[j].z * v[j].z + v[j].w * v[j].w); }
        const float r = rsqrtf(wave_sum(s) * (1.f / D_MODEL) + NORM_EPS);
        float4* orow = (float4*)(xout + (size_t)m * D_MODEL) + F.lane; float s2 = 0.f;
#pragma unroll
        for (int j = 0; j < 4; ++j) { const float4 ww = wr[64 * j], xx = xr[64 * j]; float4 o; o.x = xx.x + v[j].x * r * ww.x; o.y = xx.y + v[j].y * r * ww.y; o.z = xx.z + v[j].z * r * ww.z; o.w = xx.w + v[j].w * r * ww.w;
            orow[64 * j] = o; v[j] = o; s2 += (o.x * o.x + o.y * o.y) + (o.z * o.z + o.w * o.w); }
        if (xn) {
            const float r2 = rsqrtf(wave_sum(s2) * (1.f / D_MODEL) + NORM_EPS);
            const float4* w2r = (const float4*)w2 + F.lane; uint2* o8 = (uint2*)(xn + (size_t)m * D_MODEL) + F.lane;
#pragma unroll
            for (int j = 0; j < 4; ++j) { const float4 ww = w2r[64 * j]; uint2 o; o.x = pk_f16(v[j].x * r2 * ww.x, v[j].y * r2 * ww.y); o.y = pk_f16(v[j].z * r2 * ww.z, v[j].w * r2 * ww.w); o8[64 * j] = o; }
        }
    }
}
__device__ __forceinline__ void naive_conv_glu(const Frame& F, const f16_t* ub, const float* cw, const float* cb, f16_t* actb) {
    for (int idx = F.bid * NTHREADS + F.tid; idx < SEQ * 704; idx += F.G * NTHREADS) {
        const int t = idx / 704, j = (idx % 704) * 4, uc = (j >> 7) * 256 + (j & 127);
        float ga[4], ua[4];
        { const float4 a = *(const float4*)(cb + j), c = *(const float4*)(cb + D_FF + j); ga[0] = a.x; ga[1] = a.y; ga[2] = a.z; ga[3] = a.w; ua[0] = c.x; ua[1] = c.y; ua[2] = c.z; ua[3] = c.w; }
#pragma unroll
        for (int i = 0; i < 3; ++i) { const int tt = t - 2 + i;
            if (tt >= 0) { const h4 xg = *(const h4*)(ub + (size_t)tt * (2 * D_FF) + uc), xu = *(const h4*)(ub + (size_t)tt * (2 * D_FF) + uc + 128);
                const float4 wg = *(const float4*)(cw + i * (2 * D_FF) + j), wu = *(const float4*)(cw + i * (2 * D_FF) + D_FF + j);
                ga[0] = fmaf(wg.x, (float)xg[0], ga[0]); ga[1] = fmaf(wg.y, (float)xg[1], ga[1]); ga[2] = fmaf(wg.z, (float)xg[2], ga[2]); ga[3] = fmaf(wg.w, (float)xg[3], ga[3]);
                ua[0] = fmaf(wu.x, (float)xu[0], ua[0]); ua[1] = fmaf(wu.y, (float)xu[1], ua[1]); ua[2] = fmaf(wu.z, (float)xu[2], ua[2]); ua[3] = fmaf(wu.w, (float)xu[3], ua[3]); } }
        uint2 o; o.x = pk_f16(gelu_tanh_f(ga[0]) * ua[0], gelu_tanh_f(ga[1]) * ua[1]); o.y = pk_f16(gelu_tanh_f(ga[2]) * ua[2], gelu_tanh_f(ga[3]) * ua[3]);
        *(uint2*)(actb + (size_t)t * D_FF + j) = o;
    }
}

constexpr int DNI_CHUNK = 73728, DNI_NEGW = 0, DNI_QD = 16384, DNI_KDT = 32768, DNI_A = 49152, DNI_UT = 57344, DNI_STAGE = 57344;
constexpr size_t WS_EGL = 2 * MiB + 512 * 1024;
__device__ __forceinline__ int perm64(int j) { const int rem = j & 31; return (j & ~31) + 8 * ((rem >> 2) & 3) + 4 * (rem >> 4) + (rem & 3); }
__device__ __forceinline__ int imgW_b(int i, int dp) { return i * 256 + ((((dp >> 3) ^ (i & 15))) << 4) + (dp & 7) * 2; }
__device__ __forceinline__ int imgK_b(int row, int cp) { return (row >> 1) * 256 + (((((row & 1) << 3) | (cp >> 3)) ^ ((row >> 1) & 7)) << 4) + (cp & 7) * 2; }
typedef float f32x4 __attribute__((ext_vector_type(4)));
typedef unsigned u32x4v __attribute__((ext_vector_type(4)));
typedef unsigned u32x2v __attribute__((ext_vector_type(2)));

constexpr int PREP_HALF_LDS = 69632, PREP_ROWB = 272;
static_assert(2 * PREP_HALF_LDS <= LDSCTL_OFF, "prep LDS");
__device__ __forceinline__ void dn_prep(const Frame& F, const f16_t* proj, const float* gates, const float* cw, const float* a_log, const float* dt_bias, unsigned char* dni, float* egl) {
    const int half = F.tid >> 8, th0 = F.tid & 255;
    LAS unsigned char* base = F.lds + half * PREP_HALF_LDS;
    LAS unsigned char* Qh = base; LAS unsigned char* Kh = base + 17408; LAS unsigned char* Vh = base + 34816;
    LAS float* Lm = (LAS float*)(base + 52224); LAS float* sbeta = (LAS float*)(base + 68608); LAS float* sG = sbeta + 64; LAS float* seG = sbeta + 128;
    for (int pass = F.bid; pass < 1024; pass += F.G) {
        int th = th0; asm volatile("" : "+v"(th));
        const int lane = th & 63, fr = lane & 15, fq = lane >> 4, wq = th >> 6;
        const int item = 2 * pass + half, bc = item >> 2, h = item & 3, b = bc >> 7, c = bc & 127, t0 = c * 64;
        const size_t row0 = (size_t)b * SEQ + t0;
        unsigned char* out = dni + (size_t)((b * 4 + h) * 128 + c) * DNI_CHUNK;
#pragma unroll 1
        for (int j = 0; j < 12; ++j) {
            const int m = j >> 2, i = (th >> 4) + 16 * (j & 3), cg = th & 15, cc = m * 512 + h * 128 + 8 * cg;
            float acc[8];
#pragma unroll
            for (int e = 0; e < 8; ++e) acc[e] = 0.f;
#pragma unroll
            for (int tap = 0; tap < 4; ++tap) {
                if (t0 + i - 3 + tap >= 0) {
                    float x[8]; ld8(proj + (row0 + i - 3 + tap) * PROJ_W + COL_QKVC + cc, x);
                    const float4 w0 = *(const float4*)(cw + tap * 1536 + cc), w1 = *(const float4*)(cw + tap * 1536 + cc + 4);
                    acc[0] = fmaf(w0.x, x[0], acc[0]); acc[1] = fmaf(w0.y, x[1], acc[1]); acc[2] = fmaf(w0.z, x[2], acc[2]); acc[3] = fmaf(w0.w, x[3], acc[3]);
                    acc[4] = fmaf(w1.x, x[4], acc[4]); acc[5] = fmaf(w1.y, x[5], acc[5]); acc[6] = fmaf(w1.z, x[6], acc[6]); acc[7] = fmaf(w1.w, x[7], acc[7]);
                }
            }
            float ss = 0.f;
#pragma unroll
            for (int e = 0; e < 8; ++e) { acc[e] = silu_f(acc[e]); ss = fmaf(acc[e], acc[e], ss); }
            ss += __shfl_xor(ss, 1); ss += __shfl_xor(ss, 2); ss += __shfl_xor(ss, 4); ss += __shfl_xor(ss, 8);
            float r = 1.f;
            if (m == 0) r = rsqrtf(ss + NORM_EPS) * 0.08838834764831845f; else if (m == 1) r = rsqrtf(ss + NORM_EPS);
            u32x4v o; o.x = pk_f16(acc[0] * r, acc[1] * r); o.y = pk_f16(acc[2] * r, acc[3] * r); o.z = pk_f16(acc[4] * r, acc[5] * r); o.w = pk_f16(acc[6] * r, acc[7] * r);
            *(LAS u32x4v*)(base + m * 17408 + i * PREP_ROWB + cg * 16) = o;
        }
        if (th < 64) {
            const size_t bt = row0 + th;
            const float bcv = gates[bt * 8 + h], ac = gates[bt * 8 + 4 + h] + dt_bias[h];
            const float be = 1.f / (1.f + expf(-bcv));
            const float sp = ac > 20.f ? ac : log1pf(expf(ac));
            float gs = -expf(a_log[h]) * sp;
#pragma unroll
            for (int o = 1; o < 64; o <<= 1) { const float up = __shfl_up(gs, o); if (lane >= o) gs += up; }
            sbeta[th] = be; sG[th] = gs; seG[th] = expf(gs);
        }
        __syncthreads();
        {
            const int mt = wq;
            h8 Ak[4], Aq[4];
#pragma unroll
            for (int s = 0; s < 4; ++s) { Ak[s] = *(const LAS h8*)(Kh + (16 * mt + fr) * PREP_ROWB + (32 * s + 8 * fq) * 2); Aq[s] = *(const LAS h8*)(Qh + (16 * mt + fr) * PREP_ROWB + (32 * s + 8 * fq) * 2); }
#pragma unroll
            for (int nt = 0; nt < 4; ++nt) {
                f32x4 kk = {0.f, 0.f, 0.f, 0.f}, qk = {0.f, 0.f, 0.f, 0.f};
#pragma unroll
                for (int s = 0; s < 4; ++s) { const h8 Bk = *(const LAS h8*)(Kh + (16 * nt + fr) * PREP_ROWB + (32 * s + 8 * fq) * 2);
                    kk = __builtin_amdgcn_mfma_f32_16x16x32_f16(Ak[s], Bk, kk, 0, 0, 0); qk = __builtin_amdgcn_mfma_f32_16x16x32_f16(Aq[s], Bk, qk, 0, 0, 0); }
                const int jc = 16 * nt + fr; const float Gj = sG[jc];
#pragma unroll
                for (int r = 0; r < 4; ++r) { const int i = 16 * mt + 4 * fq + r; const float dec = __expf(sG[i] - Gj);
                    Lm[i * 64 + jc] = (jc < i) ? sbeta[i] * kk[r] * dec : 0.f;
                    *(f16_t*)(out + DNI_A + imgK_b(i, perm64(jc))) = f2h((jc <= i) ? qk[r] * dec : 0.f); }
            }
        }
        __syncthreads();
        {
            float x[64];
            const bool isU = th < 128; const int cidx = th & 127;
            const LAS unsigned char* src = (isU ? Vh : Kh) + cidx * 2;
#pragma unroll
            for (int i = 0; i < 64; ++i) {
                const float eGi = seG[i]; const float rv = h2f(*(const LAS f16_t*)(src + i * PREP_ROWB)) * sbeta[i] * (isU ? 1.f : eGi);
                float a0 = rv, a1 = 0.f, a2 = 0.f, a3 = 0.f;
#pragma unroll
                for (int j4 = 0; j4 < (i + 3) / 4; ++j4) { const f32x4 lv = *(const LAS f32x4*)(Lm + i * 64 + 4 * j4);
                    if (4 * j4 + 0 < i) a0 = fmaf(-lv.x, x[4 * j4 + 0], a0); if (4 * j4 + 1 < i) a1 = fmaf(-lv.y, x[4 * j4 + 1], a1);
                    if (4 * j4 + 2 < i) a2 = fmaf(-lv.z, x[4 * j4 + 2], a2); if (4 * j4 + 3 < i) a3 = fmaf(-lv.w, x[4 * j4 + 3], a3); }
                x[i] = (a0 + a1) + (a2 + a3);
                asm volatile("" ::: "memory");
            }
            if (isU) {
                u32x4v* up = (u32x4v*)(out + DNI_UT + cidx * 128);
#pragma unroll
                for (int q8 = 0; q8 < 8; ++q8) { u32x4v o; o.x = pk_f16(x[8 * q8], x[8 * q8 + 1]); o.y = pk_f16(x[8 * q8 + 2], x[8 * q8 + 3]); o.z = pk_f16(x[8 * q8 + 4], x[8 * q8 + 5]); o.w = pk_f16(x[8 * q8 + 6], x[8 * q8 + 7]); up[q8] = o; }
            } else {
                const int dp = perm64(cidx);
#pragma unroll
                for (int i = 0; i < 64; ++i) *(f16_t*)(out + DNI_NEGW + imgW_b(i, dp)) = f2h(-x[i]);
            }
        }
#pragma unroll
        for (int j = 0; j < 4; ++j) {
            const int i = (th >> 4) + 16 * j, cg = th & 15; const float sc = seG[i];
            const h8 qv = *(const LAS h8*)(Qh + i * PREP_ROWB + cg * 16);
            const int s32 = (cg >> 2) * 32, jh = (cg & 3) >> 1;
            u32x2v lo, hi; lo.x = pk_f16((float)qv[0] * sc, (float)qv[1] * sc); lo.y = pk_f16((float)qv[2] * sc, (float)qv[3] * sc); hi.x = pk_f16((float)qv[4] * sc, (float)qv[5] * sc); hi.y = pk_f16((float)qv[6] * sc, (float)qv[7] * sc);
            *(u32x2v*)(out + DNI_QD + imgW_b(i, s32 + 8 * (2 * (cg & 1)) + 4 * jh)) = lo;
            *(u32x2v*)(out + DNI_QD + imgW_b(i, s32 + 8 * (2 * (cg & 1) + 1) + 4 * jh)) = hi;
        }
        {
            const int d = th & 127, ih = th >> 7; const float Gl = sG[63];
            float kv[32];
#pragma unroll
            for (int rem = 0; rem < 32; ++rem) { const int i = 32 * ih + rem; kv[8 * ((rem >> 2) & 3) + 4 * (rem >> 4) + (rem & 3)] = h2f(*(const LAS f16_t*)(Kh + i * PREP_ROWB + d * 2)) * __expf(Gl - sG[i]); }
#pragma unroll
            for (int q8 = 0; q8 < 4; ++q8) { u32x4v o; o.x = pk_f16(kv[8 * q8], kv[8 * q8 + 1]); o.y = pk_f16(kv[8 * q8 + 2], kv[8 * q8 + 3]); o.z = pk_f16(kv[8 * q8 + 4], kv[8 * q8 + 5]); o.w = pk_f16(kv[8 * q8 + 6], kv[8 * q8 + 7]);
                *(u32x4v*)(out + DNI_KDT + imgK_b(d, 32 * ih + 8 * q8)) = o; }
            if (th == 0) egl[(b * 4 + h) * 128 + c] = seG[63];
        }
        __syncthreads();
    }
}

constexpr int SCAN_PART_OFF = 2 * DNI_STAGE;
__device__ __forceinline__ void dn_scan(const Frame& F, const unsigned char* dni, const float* egl, const f16_t* proj, const float* nw, f16_t* mixed) {
    if (F.bid >= 16) return;
    const int bh = F.bid, b = bh >> 2, h = bh & 3, wv = F.wave, lane = F.lane, fr = lane & 15, fq = lane >> 4, tid = F.tid;
    const unsigned char* src = dni + (size_t)(bh * 128) * DNI_CHUNK;
    LAS unsigned char* lds = F.lds;
    f32x4 S[8];
#pragma unroll
    for (int m = 0; m < 8; ++m) S[m] = (f32x4){0.f, 0.f, 0.f, 0.f};
    u32x4v st[7]; u32x2v un[4]; f16_t zn[16]; float egn;
    const f16_t* zbase = proj + (size_t)b * SEQ * PROJ_W + COL_Z + h * 128 + 16 * wv + fr;
    const float nwe = nw[16 * wv + fr];
#define DN_LOAD(cc) do { const unsigned char* s_ = src + (size_t)(cc) * DNI_CHUNK; \
        _Pragma("unroll") for (int k = 0; k < 7; ++k) st[k] = *(const u32x4v*)(s_ + tid * 16 + 8192 * k); \
        _Pragma("unroll") for (int mt = 0; mt < 4; ++mt) un[mt] = *(const u32x2v*)(s_ + DNI_UT + (16 * wv + fr) * 128 + (16 * mt + 4 * fq) * 2); \
        _Pragma("unroll") for (int mt = 0; mt < 4; ++mt) _Pragma("unroll") for (int r = 0; r < 4; ++r) zn[4 * mt + r] = zbase[(size_t)((cc) * 64 + 16 * mt + 4 * fq + r) * PROJ_W]; \
        egn = egl[bh * 128 + (cc)]; } while (0)
    DN_LOAD(0);
#pragma unroll
    for (int k = 0; k < 7; ++k) *(LAS u32x4v*)(lds + tid * 16 + 8192 * k) = st[k];
    __syncthreads();
    f32x4 op[4]; f16_t zp[16];
#pragma unroll
    for (int mt = 0; mt < 4; ++mt) op[mt] = (f32x4){0.f, 0.f, 0.f, 0.f};
#pragma unroll
    for (int i = 0; i < 16; ++i) zp[i] = 0;
#pragma unroll 1
    for (int c = 0; c < 128; ++c) {
        LAS unsigned char* cur = lds + (c & 1) * DNI_STAGE; LAS unsigned char* nxt = lds + ((c + 1) & 1) * DNI_STAGE;
        f32x4 vn[4]; f16_t zc[16]; const float eg = egn;
#pragma unroll
        for (int mt = 0; mt < 4; ++mt) { const h4 uu = __builtin_bit_cast(h4, un[mt]); vn[mt] = (f32x4){(float)uu[0], (float)uu[1], (float)uu[2], (float)uu[3]}; }
#pragma unroll
        for (int i = 0; i < 16; ++i) zc[i] = zn[i];
        if (c + 1 < 128) DN_LOAD(c + 1);
        if (c > 0) {
            const LAS float* part = (const LAS float*)(lds + SCAN_PART_OFF + ((c - 1) & 1) * 2048);
#pragma unroll
            for (int mt = 0; mt < 4; ++mt)
#pragma unroll
                for (int r = 0; r < 4; ++r) { const int i = 16 * mt + 4 * fq + r; const f32x4 p0 = *(const LAS f32x4*)(part + i * 8), p1 = *(const LAS f32x4*)(part + i * 8 + 4);
                    const float ss = ((p0.x + p0.y) + (p0.z + p0.w)) + ((p1.x + p1.y) + (p1.z + p1.w)); const float rn = rsqrtf(ss * (1.f / 128.f) + NORM_EPS);
                    mixed[((size_t)b * SEQ + (c - 1) * 64 + i) * D_MODEL + 512 + h * 128 + 16 * wv + fr] = f2h(op[mt][r] * rn * nwe * silu_f(h2f(zp[4 * mt + r]))); }
        }
        h8 Sb[4];
#pragma unroll
        for (int s = 0; s < 4; ++s) Sb[s] = (h8){(_Float16)S[2 * s][0], (_Float16)S[2 * s][1], (_Float16)S[2 * s][2], (_Float16)S[2 * s][3], (_Float16)S[2 * s + 1][0], (_Float16)S[2 * s + 1][1], (_Float16)S[2 * s + 1][2], (_Float16)S[2 * s + 1][3]};
        f32x4 o[4];
#pragma unroll
        for (int mt = 0; mt < 4; ++mt) { const int row = 16 * mt + fr; o[mt] = (f32x4){0.f, 0.f, 0.f, 0.f};
#pragma unroll
            for (int s = 0; s < 4; ++s) { const int off = row * 256 + (((4 * s + fq) ^ (row & 15)) << 4);
                const h8 aw = *(const LAS h8*)(cur + DNI_NEGW + off), aq = *(const LAS h8*)(cur + DNI_QD + off);
                vn[mt] = __builtin_amdgcn_mfma_f32_16x16x32_f16(aw, Sb[s], vn[mt], 0, 0, 0); o[mt] = __builtin_amdgcn_mfma_f32_16x16x32_f16(aq, Sb[s], o[mt], 0, 0, 0); } }
        h8 Vb[2];
#pragma unroll
        for (int s = 0; s < 2; ++s) Vb[s] = (h8){(_Float16)vn[2 * s][0], (_Float16)vn[2 * s][1], (_Float16)vn[2 * s][2], (_Float16)vn[2 * s][3], (_Float16)vn[2 * s + 1][0], (_Float16)vn[2 * s + 1][1], (_Float16)vn[2 * s + 1][2], (_Float16)vn[2 * s + 1][3]};
#pragma unroll
        for (int mt = 0; mt < 4; ++mt) { const int row = 16 * mt + fr;
#pragma unroll
            for (int s = 0; s < 2; ++s) { const int off = (row >> 1) * 256 + (((((row & 1) << 3) | (4 * s + fq)) ^ ((row >> 1) & 7)) << 4);
                o[mt] = __builtin_amdgcn_mfma_f32_16x16x32_f16(*(const LAS h8*)(cur + DNI_A + off), Vb[s], o[mt], 0, 0, 0); } }
#pragma unroll
        for (int m = 0; m < 8; ++m) { const int row = 16 * m + fr; S[m] = S[m] * eg;
#pragma unroll
            for (int s = 0; s < 2; ++s) { const int off = (row >> 1) * 256 + (((((row & 1) << 3) | (4 * s + fq)) ^ ((row >> 1) & 7)) << 4);
                S[m] = __builtin_amdgcn_mfma_f32_16x16x32_f16(*(const LAS h8*)(cur + DNI_KDT + off), Vb[s], S[m], 0, 0, 0); } }
        {
            LAS float* part = (LAS float*)(lds + SCAN_PART_OFF + (c & 1) * 2048);
#pragma unroll
            for (int mt = 0; mt < 4; ++mt)
#pragma unroll
                for (int r = 0; r < 4; ++r) { float ss = o[mt][r] * o[mt][r]; ss += __shfl_xor(ss, 1); ss += __shfl_xor(ss, 2); ss += __shfl_xor(ss, 4); ss += __shfl_xor(ss, 8);
                    if (fr == 0) part[(16 * mt + 4 * fq + r) * 8 + wv] = ss; }
        }
        if (c + 1 < 128) {
#pragma unroll
            for (int k = 0; k < 7; ++k) *(LAS u32x4v*)(nxt + tid * 16 + 8192 * k) = st[k];
        }
#pragma unroll
        for (int mt = 0; mt < 4; ++mt) op[mt] = o[mt];
#pragma unroll
        for (int i = 0; i < 16; ++i) zp[i] = zc[i];
        __syncthreads();
    }
    {
        const LAS float* part = (const LAS float*)(lds + SCAN_PART_OFF + (127 & 1) * 2048);
#pragma unroll
        for (int mt = 0; mt < 4; ++mt)
#pragma unroll
            for (int r = 0; r < 4; ++r) { const int i = 16 * mt + 4 * fq + r; const f32x4 p0 = *(const LAS f32x4*)(part + i * 8), p1 = *(const LAS f32x4*)(part + i * 8 + 4);
                const float ss = ((p0.x + p0.y) + (p0.z + p0.w)) + ((p1.x + p1.y) + (p1.z + p1.w)); const float rn = rsqrtf(ss * (1.f / 128.f) + NORM_EPS);
                mixed[((size_t)b * SEQ + 127 * 64 + i) * D_MODEL + 512 + h * 128 + 16 * wv + fr] = f2h(op[mt][r] * rn * nwe * silu_f(h2f(zp[4 * mt + r]))); }
    }
#undef DN_LOAD
    __syncthreads();
}

typedef float f32x16 __attribute__((ext_vector_type(16)));
typedef short s16x4 __attribute__((ext_vector_type(4)));
constexpr float ATT_C2 = 0.125f * 1.4426950408889634f, LOG2E = 1.4426950408889634f, ATT_NEG = -1e30f;
constexpr int ATT_BCAST_OFF = 65536;
__device__ __forceinline__ float xhalf_max(float m) { auto rr = __builtin_amdgcn_permlane32_swap(__float_as_uint(m), __float_as_uint(m), false, false); return fmaxf(__uint_as_float(rr[0]), __uint_as_float(rr[1])); }
__device__ __forceinline__ float xhalf_sum(float m) { auto rr = __builtin_amdgcn_permlane32_swap(__float_as_uint(m), __float_as_uint(m), false, false); return __uint_as_float(rr[0]) + __uint_as_float(rr[1]); }

__device__ __forceinline__ void att_stage_tile(const f16_t* proj, long krow0, long rowmin, int kcol, int vcol, LAS unsigned char* Kt, LAS unsigned char* Vt, int tid) {
    { long r = krow0 + (tid & 63); r = r < rowmin ? rowmin : r;
      *(LAS u32x4v*)(Kt + (tid >> 6) * 1024 + (tid & 63) * 16) = *(const u32x4v*)(proj + r * PROJ_W + kcol + (tid >> 6) * 8); }
    { long r = krow0 + 16 * ((tid >> 6) & 3) + ((tid & 63) >> 2); r = r < rowmin ? rowmin : r;
      *(LAS u32x4v*)(Vt + tid * 16) = *(const u32x4v*)(proj + r * PROJ_W + vcol + 32 * (tid >> 8) + 8 * (tid & 3)); }
}
__device__ __forceinline__ void att_tile(const LAS unsigned char* Kt, const LAS unsigned char* Vt, const h8 (&qf)[4], int lane, int k0, int tq, float sl2, int W, bool rowvalid, bool posmask,
                                         float& m, float& l, f32x16& o0, f32x16& o1) {
    const int r32 = lane & 31, hi = lane >> 5;
    f32x16 p0, p1;
#pragma unroll
    for (int r = 0; r < 16; ++r) { p0[r] = 0.f; p1[r] = 0.f; }
    const LAS unsigned char* kb = Kt + hi * 1024 + r32 * 16;
#pragma unroll
    for (int d0 = 0; d0 < 4; ++d0) { const h8 b0 = *(const LAS h8*)(kb + d0 * 2048), b1 = *(const LAS h8*)(kb + d0 * 2048 + 512);
        p0 = __builtin_amdgcn_mfma_f32_32x32x16_f16(b0, qf[d0], p0, 0, 0, 0); p1 = __builtin_amdgcn_mfma_f32_32x32x16_f16(b1, qf[d0], p1, 0, 0, 0); }
    const int kq = k0 + 4 * hi - tq;
    const float c0 = sl2 * (float)kq;
    float mx = ATT_NEG;
#pragma unroll
    for (int r = 0; r < 16; ++r) { const int kr = (r & 3) + 8 * (r >> 2);
        float s0 = fmaf(p0[r], ATT_C2, fmaf(sl2, (float)kr, c0)), s1 = fmaf(p1[r], ATT_C2, fmaf(sl2, (float)(kr + 32), c0));
        bool v0 = rowvalid, v1 = rowvalid;
        if (posmask) { const int d0 = -(kq + kr), d1 = d0 - 32; v0 = v0 && d0 >= 0 && d0 < W && (tq - d0) >= 0; v1 = v1 && d1 >= 0 && d1 < W && (tq - d1) >= 0; }
        s0 = v0 ? s0 : ATT_NEG; s1 = v1 ? s1 : ATT_NEG; p0[r] = s0; p1[r] = s1; mx = fmaxf(mx, fmaxf(s0, s1)); }
    mx = xhalf_max(mx);
    const float mn = fmaxf(m, mx), alpha = __builtin_amdgcn_exp2f(m - mn);
    m = mn; l *= alpha;
#pragma unroll
    for (int r = 0; r < 16; ++r) { o0[r] *= alpha; o1[r] *= alpha; }
    float ls = 0.f;
#pragma unroll
    for (int r = 0; r < 16; ++r) { p0[r] = __builtin_amdgcn_exp2f(p0[r] - mn); p1[r] = __builtin_amdgcn_exp2f(p1[r] - mn); ls += p0[r] + p1[r]; }
    l += ls;
    h8 pa[4];
#pragma unroll
    for (int j = 0; j < 8; ++j) { pa[0][j] = (_Float16)p0[j]; pa[1][j] = (_Float16)p0[8 + j]; pa[2][j] = (_Float16)p1[j]; pa[3][j] = (_Float16)p1[8 + j]; }
    const LAS unsigned char* vb = Vt + (4 * hi + ((lane & 15) >> 2)) * 64 + ((lane >> 4) & 1) * 32 + (lane & 3) * 8;
#pragma unroll
    for (int ks = 0; ks < 4; ++ks) {
        const s16x4 l0 = __builtin_amdgcn_ds_read_tr16_b64_v4i16((LAS s16x4*)(vb + ks * 1024)), h0 = __builtin_amdgcn_ds_read_tr16_b64_v4i16((LAS s16x4*)(vb + ks * 1024 + 512));
        const s16x4 l1 = __builtin_amdgcn_ds_read_tr16_b64_v4i16((LAS s16x4*)(vb + 4096 + ks * 1024)), h1 = __builtin_amdgcn_ds_read_tr16_b64_v4i16((LAS s16x4*)(vb + 4096 + ks * 1024 + 512));
        typedef short s16x8 __attribute__((ext_vector_type(8)));
        const s16x8 a0 = {l0[0], l0[1], l0[2], l0[3], h0[0], h0[1], h0[2], h0[3]}, a1 = {l1[0], l1[1], l1[2], l1[3], h1[0], h1[1], h1[2], h1[3]};
        o0 = __builtin_amdgcn_mfma_f32_32x32x16_f16(__builtin_bit_cast(h8, a0), pa[ks], o0, 0, 0, 0);
        o1 = __builtin_amdgcn_mfma_f32_32x32x16_f16(__builtin_bit_cast(h8, a1), pa[ks], o1, 0, 0, 0);
    }
}
__device__ __forceinline__ void att_store(f16_t* orow, int hi, float l, const f32x16& o0, const f32x16& o1) {
    const float rl = 1.f / xhalf_sum(l);
#pragma unroll
    for (int g = 0; g < 4; ++g) {
        u32x2v w0, w1; w0.x = pk_f16(o0[4 * g] * rl, o0[4 * g + 1] * rl); w0.y = pk_f16(o0[4 * g + 2] * rl, o0[4 * g + 3] * rl);
        w1.x = pk_f16(o1[4 * g] * rl, o1[4 * g + 1] * rl); w1.y = pk_f16(o1[4 * g + 2] * rl, o1[4 * g + 3] * rl);
        *(u32x2v*)(orow + 8 * g + 4 * hi) = w0; *(u32x2v*)(orow + 32 + 8 * g + 4 * hi) = w1; }
}
__device__ __forceinline__ void att_load_q(const f16_t* qrow, int hi, h8 (&qf)[4]) {
#pragma unroll
    for (int d0 = 0; d0 < 4; ++d0) qf[d0] = *(const h8*)(qrow + 16 * d0 + 8 * hi);
}

__device__ __forceinline__ void swa_phase(const Frame& F, const f16_t* proj, const float* sinks, f16_t* mixed) {
    LAS unsigned char* lds = F.lds;
    const int lane = F.lane, r32 = lane & 31, hi = lane >> 5, w = F.wave;
    for (int u = F.bid; u < 512; u += F.G) {
        const int b = u >> 7, hkv = (u >> 6) & 1, blk = u & 63;
        const long rb = (long)b * SEQ; const int base = blk * 128 - 128;
        __syncthreads();
#pragma unroll
        for (int tl = 0; tl < 4; ++tl) att_stage_tile(proj, rb + base + 64 * tl, rb, COL_KA + hkv * 64, COL_VA + hkv * 64, lds + tl * 8192, lds + 32768 + tl * 8192, F.tid);
        __syncthreads();
        const int hq = 2 * hkv + (w >> 2), tq = blk * 128 + 32 * (w & 3) + r32;
        const float sl2 = exp2f(-(float)(2 * hq + 1)) * LOG2E;
        h8 qf[4]; att_load_q(proj + (rb + tq) * PROJ_W + COL_QA + hq * 64, hi, qf);
        float m = sinks[hq] * LOG2E, l = hi == 0 ? 1.f : 0.f; f32x16 o0, o1;
#pragma unroll
        for (int r = 0; r < 16; ++r) { o0[r] = 0.f; o1[r] = 0.f; }
        const int tlo = (w & 2) ? 1 : 0;
#pragma unroll 1
        for (int tl = tlo; tl < tlo + 3; ++tl) {
            if (base + 64 * tl + 63 < 0) continue;
            att_tile(lds + tl * 8192, lds + 32768 + tl * 8192, qf, lane, base + 64 * tl, tq, sl2, 128, true, true, m, l, o0, o1);
        }
        att_store(mixed + (rb + tq) * D_MODEL + hq * 64, hi, l, o0, o1);
    }
    __syncthreads();
}

__device__ __forceinline__ void moba_phase(const Frame& F, const f16_t* proj, const float* kmean, f16_t* mixed, unsigned* qctr) {
    LAS unsigned char* lds = F.lds;
    const int lane = F.lane, r32 = lane & 31, hi = lane >> 5, w = F.wave;
    volatile LAS unsigned* bc = (volatile LAS unsigned*)(lds + ATT_BCAST_OFF);
    for (;;) {
        __syncthreads();
        if (F.tid == 0) bc[0] = __hip_atomic_fetch_add(qctr, 1u, __ATOMIC_RELAXED, __HIP_MEMORY_SCOPE_AGENT);
        __syncthreads();
        const unsigned u = bc[0];
        if (u >= 512u) break;
        const int j0 = 31 - (int)(u >> 4), bh = (int)(u & 15), b = bh >> 2, h = bh & 3;
        const long rb = (long)b * SEQ;
        const int tq = 256 * j0 + 32 * w + r32;
        const float sl2 = exp2f(-(float)(2 * h + 2)) * LOG2E;
        h8 qf[4]; att_load_q(proj + (rb + tq) * PROJ_W + COL_QB + h * 64, hi, qf);
        unsigned sel = 0u;
        {
            float g0 = -3e38f, g1 = -3e38f, g2 = -3e38f; int i0 = -1, i1 = -1, i2 = -1;
            for (int n = 0; n < j0; ++n) {
                const float* kp = kmean + (size_t)((b * 4 + h) * 32 + n) * 64 + 8 * hi;
                float d = 0.f;
#pragma unroll
                for (int d0 = 0; d0 < 4; ++d0) { const float4 k0 = *(const float4*)(kp + 16 * d0), k1 = *(const float4*)(kp + 16 * d0 + 4);
                    d = fmaf((float)qf[d0][0], k0.x, d); d = fmaf((float)qf[d0][1], k0.y, d); d = fmaf((float)qf[d0][2], k0.z, d); d = fmaf((float)qf[d0][3], k0.w, d);
                    d = fmaf((float)qf[d0][4], k1.x, d); d = fmaf((float)qf[d0][5], k1.y, d); d = fmaf((float)qf[d0][6], k1.z, d); d = fmaf((float)qf[d0][7], k1.w, d); }
                d = xhalf_sum(d);
                if (d > g0) { g2 = g1; i2 = i1; g1 = g0; i1 = i0; g0 = d; i0 = n; }
                else if (d > g1) { g2 = g1; i2 = i1; g1 = d; i1 = n; }
                else if (d > g2) { g2 = d; i2 = n; }
            }
            if (i0 >= 0) sel |= 1u << i0; if (i1 >= 0) sel |= 1u << i1; if (i2 >= 0) sel |= 1u << i2;
        }
        float m = ATT_NEG, l = 0.f; f32x16 o0, o1;
#pragma unroll
        for (int r = 0; r < 16; ++r) { o0[r] = 0.f; o1[r] = 0.f; }
#pragma unroll
        for (int tl = 0; tl < 4; ++tl) att_stage_tile(proj, rb + 256 * j0 + 64 * tl, rb, COL_KB + h * 64, COL_VB + h * 64, lds + tl * 8192, lds + 32768 + tl * 8192, F.tid);
        __syncthreads();
        { const int td = w >> 1;
          att_tile(lds + td * 8192, lds + 32768 + td * 8192, qf, lane, 256 * j0 + 64 * td, tq, sl2, 1 << 30, true, true, m, l, o0, o1);
#pragma unroll 1
          for (int tl = 0; tl < td; ++tl) att_tile(lds + tl * 8192, lds + 32768 + tl * 8192, qf, lane, 256 * j0 + 64 * tl, tq, sl2, 1 << 30, true, false, m, l, o0, o1); }
#pragma unroll 1
        for (int n = j0 - 1; n >= 0; --n) {
            __syncthreads();
#pragma unroll
            for (int tl = 0; tl < 4; ++tl) att_stage_tile(proj, rb + 256 * n + 64 * tl, rb, COL_KB + h * 64, COL_VB + h * 64, lds + tl * 8192, lds + 32768 + tl * 8192, F.tid);
            __syncthreads();
            const bool mine = (sel >> n) & 1u;
            if (__any(mine)) {
#pragma unroll 1
                for (int tl = 0; tl < 4; ++tl) att_tile(lds + tl * 8192, lds + 32768 + tl * 8192, qf, lane, 256 * n + 64 * tl, tq, sl2, 1 << 30, mine, false, m, l, o0, o1);
            }
        }
        att_store(mixed + (rb + tq) * D_MODEL + 256 + h * 64, hi, l, o0, o1);
    }
    __syncthreads();
}

__global__ void __launch_bounds__(NTHREADS, 2) fwd_kernel(Args args) {
    extern __shared__ __attribute__((aligned(16))) unsigned char lds[];
    Frame F;
    F.lds = (LAS unsigned char*)lds;
    F.tid = threadIdx.x; F.lane = F.tid & 63; F.wave = __builtin_amdgcn_readfirstlane(F.tid >> 6);
    F.G = gridDim.x; F.bid = blockIdx.x;
    gu32* ctl0 = (gu32*)(args.ws + WS_CTL);
    for (int u = F.tid; u < (LDS_BYTES - LDSCTL_OFF) / 4; u += NTHREADS) ((LAS unsigned*)(F.lds + LDSCTL_OFF))[u] = 0u;
    __syncthreads();
    XcdBarrier bar = xcd_barrier_post((unsigned*)(ctl0 + CW_BAR), (volatile LAS unsigned*)(F.lds + MISC_OFF) + 8);
#define GRID_BAR() do { XcdBarrier b_ = bar; asm volatile("" : "+s"(b_.x), "+s"(b_.bar)); xcd_barrier(b_); } while (0)

    const int wave0 = F.wave;
    p0_prologue(F, args);
    GRID_BAR();
    constexpr int PH_PER_LAYER = 16, NPH = DEPTH * PH_PER_LAYER;
    for (int ph = 0; ph < NPH; ++ph) {
        int p = ph; asm volatile("" : "+s"(p));
        { int w_ = wave0; asm volatile("" : "+s"(w_)); int l_ = __builtin_amdgcn_mbcnt_hi(~0u, __builtin_amdgcn_mbcnt_lo(~0u, 0u)); asm volatile("" : "+v"(l_)); F.wave = w_; F.lane = l_; F.tid = w_ * 64 + l_; }
        { int b_ = blockIdx.x, g_ = gridDim.x; asm volatile("" : "+s"(b_), "+s"(g_)); F.bid = b_; F.G = g_; }
        unsigned char* ws = args.ws; asm volatile("" : "+s"(ws));
        gu32* ctl = (gu32*)(ws + WS_CTL);
        f16_t* XN = (f16_t*)(ws + WS_XN); f16_t* PROJ = (f16_t*)(ws + WS_PROJ); f16_t* MIXED = (f16_t*)(ws + WS_MIXED); f16_t* ACT = (f16_t*)(ws + WS_ACT);
        float* GATES = (float*)(ws + WS_GATES); float* BETA = (float*)(ws + WS_BG); float* GG = BETA + (size_t)T_TOK * 4;
        f16_t* QKVC = (f16_t*)(ws + WS_QKVC); f16_t* OC = (f16_t*)(ws + WS_OC); float* Y1 = (float*)(ws + WS_Y1); float* Y2 = (float*)(ws + WS_Y2); f16_t* UB = (f16_t*)(ws + WS_UB);
        const int l = p / PH_PER_LAYER, k = p % PH_PER_LAYER;
        unsigned char* wb = ws + WS_W + (size_t)l * W_LAYER;
        float* kmean = (float*)(ctl + CW_KMEAN) + (size_t)l * 32768;
        if (k == 0) {
            pg8::Gemm g{XN, (const f16_t*)(wb + W_IN), T_TOK, IN_PAD, D_MODEL}; pg8::StaticOrder S; S.init(T_TOK, IN_PAD, F.G, F.bid);
            pg8::EpiProj E{PROJ, GATES, kmean};
            pg8::gemm_phase<pg8::EpiProj, pg8::StaticOrder, true, true>(F.lds + RING_OFF, g, S, E, F.tid);
        } else if (k == 1) {
            dn_prep(F, PROJ, GATES, args.in[4] + (size_t)l * 4 * 1536, args.in[5] + l * 4, args.in[6] + l * 4, ws + WS_DNI, (float*)(ws + WS_EGL));
            swa_phase(F, PROJ, args.in[3] + l * 4, MIXED);
        } else if (k == 2) {
            dn_scan(F, ws + WS_DNI, (const float*)(ws + WS_EGL), PROJ, args.in[7] + l * 128, MIXED);
            moba_phase(F, PROJ, kmean, MIXED, (unsigned*)(ctl + CW_QCTR + 64 * l));
        } else if (k == 4) {
            pg8::Gemm g{MIXED, (const f16_t*)(wb + W_OUT), T_TOK, D_MODEL, D_MODEL}; pg8::StaticOrder S; S.init(T_TOK, D_MODEL, F.G, F.bid);
            pg8::EpiF32 E{Y1, D_MODEL};
            pg8::gemm_phase<pg8::EpiF32, pg8::StaticOrder, true, true>(F.lds + RING_OFF, g, S, E, F.tid);
        } else if (k == 5) {
            naive_add_norm(F, l == 0 ? args.in[0] : args.out, Y1, args.in[9] + l * D_MODEL, args.out, args.in[10] + l * D_MODEL, XN);
        } else if (k < 14) {
            const int b = (k - 6) >> 1;
            if (((k - 6) & 1) == 0) {
                pg8::Gemm g{XN + (size_t)b * SEQ * D_MODEL, (const f16_t*)(wb + W_UP), SEQ, 2 * D_FF, D_MODEL}; pg8::StaticOrder S; S.init(SEQ, 2 * D_FF, F.G, F.bid);
                pg8::EpiF16 E{UB, 2 * D_FF};
                pg8::gemm_phase<pg8::EpiF16, pg8::StaticOrder, true, true>(F.lds + RING_OFF, g, S, E, F.tid);
            } else {
                naive_conv_glu(F, UB, args.in[12] + (size_t)l * 3 * 2 * D_FF, args.in[13] + (size_t)l * 2 * D_FF, ACT + (size_t)b * SEQ * D_FF);
            }
        } else if (k == 14) {
            pg8::Gemm g{ACT, (const f16_t*)(wb + W_DOWN), T_TOK, D_MODEL, D_FF}; pg8::StaticOrder S; S.init(T_TOK, D_MODEL, F.G, F.bid);
            pg8::EpiF32 E{Y2, D_MODEL};
            pg8::gemm_phase<pg8::EpiF32, pg8::StaticOrder, true, true>(F.lds + RING_OFF, g, S, E, F.tid);
        } else {
            naive_add_norm(F, args.out, Y2, args.in[15] + l * D_MODEL, args.out, l + 1 < DEPTH ? args.in[1] + (l + 1) * D_MODEL : nullptr, l + 1 < DEPTH ? XN : nullptr);
        }
        if (ph + 1 < NPH) GRID_BAR();
    }
}

extern "C" void kernel_launch(void* const* d_in, const int* in_sizes, int n_in, void* d_out, int out_size, void* d_ws, size_t ws_size, hipStream_t stream) {
    static int grid = 0;
    if (grid == 0) {
        if (n_in != 16 || ws_size < WS_END) { fprintf(stderr, "kernel_launch: unexpected n_in %d or ws_size %zu (< %zu)\n", n_in, ws_size, (size_t)WS_END); grid = -1; return; }
        int dev = 0, cus = 0, per_cu = 0;
        if (hipGetDevice(&dev) != hipSuccess || hipDeviceGetAttribute(&cus, hipDeviceAttributeMultiprocessorCount, dev) != hipSuccess) { grid = -1; return; }
        if (hipFuncSetAttribute((const void*)fwd_kernel, hipFuncAttributeMaxDynamicSharedMemorySize, LDS_BYTES) != hipSuccess) { fprintf(stderr, "kernel_launch: hipFuncSetAttribute failed\n"); grid = -1; return; }
        if (hipOccupancyMaxActiveBlocksPerMultiprocessor(&per_cu, (const void*)fwd_kernel, NTHREADS, LDS_BYTES) != hipSuccess || per_cu < 1) { fprintf(stderr, "kernel_launch: occupancy query failed (%d)\n", per_cu); (void)hipGetLastError(); per_cu = 1; }
        grid = cus * 1;
        if (per_cu < 1) grid = -1;
    }
    if (grid < 0) return;
    if (hipMemsetAsync((char*)d_ws + WS_CTL, 0, CTL_ZERO_BYTES, stream) != hipSuccess) return;
    Args a{};
    for (int i = 0; i < 16; ++i) a.in[i] = (const float*)d_in[i];
    a.out = (float*)d_out; a.ws = (unsigned char*)d_ws;
    hipLaunchKernelGGL(fwd_kernel, dim3(grid), dim3(NTHREADS), LDS_BYTES, stream, a);
}
```

```cpp
#include <hip/hip_runtime.h>
#include <cstdio>
#include <cstdint>

constexpr int D_MODEL = 1024, BATCH = 4, SEQ = 8192, DEPTH = 2, T_TOK = BATCH * SEQ;
constexpr int IN_WIDTH = 3336, IN_PAD = 3584, PROJ_W = 3328, D_FF = 2816;
constexpr int COL_QA = 0, COL_KA = 256, COL_VA = 384, COL_QB = 512, COL_KB = 768, COL_VB = 1024, COL_QKVC = 1280, COL_Z = 2816;
constexpr float NORM_EPS = 1e-6f;
constexpr int NWAVES = 8, NTHREADS = 512;

constexpr size_t MiB = 1u << 20;
constexpr size_t WS_CTL = 0, CTL_ZERO_BYTES = 1 * MiB;
constexpr size_t WS_GATES = 1 * MiB;
constexpr size_t WS_SEL = 2 * MiB;
constexpr size_t WS_BG = 3 * MiB;
constexpr size_t WS_W = 4 * MiB, W_LAYER = 26 * MiB;
constexpr size_t W_IN = 0, W_OUT = 7 * MiB, W_UP = 9 * MiB, W_DOWN = 20 * MiB;
constexpr size_t WS_XN = 56 * MiB;
constexpr size_t WS_DNI = 56 * MiB;
constexpr size_t WS_PROJ = 200 * MiB;
constexpr size_t WS_ACT = 200 * MiB;
constexpr size_t WS_MIXED = 408 * MiB;
constexpr size_t WS_SPARE = 472 * MiB;
constexpr size_t WS_END = 512 * MiB;
constexpr size_t WS_QKVC = 56 * MiB;
constexpr size_t WS_OC = WS_SPARE;
constexpr size_t WS_Y1 = WS_PROJ;
constexpr size_t WS_Y2 = 376 * MiB;
constexpr size_t WS_UB = 408 * MiB;
constexpr size_t WS_HALO = 120 * MiB;
constexpr int CW_BAR = 4096;
constexpr int CW_QCTR = 8192;
constexpr int CW_KMEAN = 131072;
static_assert((CW_KMEAN + 2 * 32768) * 4 <= (int)CTL_ZERO_BYTES, "ctl");

constexpr int RING_OFF = 0, RING_BYTES = 131072;
constexpr int LDS_BYTES = 163840;
constexpr int LDSCTL_OFF = LDS_BYTES - 1024, MISC_OFF = LDSCTL_OFF + 320;

typedef unsigned short f16_t;
typedef _Float16 h8 __attribute__((ext_vector_type(8)));
typedef _Float16 h4 __attribute__((ext_vector_type(4)));
typedef _Float16 h2 __attribute__((ext_vector_type(2)));
__device__ __forceinline__ int lane_id_volatile() { int l; asm volatile("v_mbcnt_lo_u32_b32 %0, -1, 0\n\tv_mbcnt_hi_u32_b32 %0, -1, %0" : "=v"(l)); return l; }
template <int M> __device__ __forceinline__ float swz_xor(float v) { return __builtin_bit_cast(float, __builtin_amdgcn_ds_swizzle(__builtin_bit_cast(int, v), (M << 10) | 0x1f)); }
__device__ __forceinline__ float sum16(float v) { v += swz_xor<1>(v); v += swz_xor<2>(v); v += swz_xor<4>(v); v += swz_xor<8>(v); return v; }
__device__ __forceinline__ unsigned pk_f16(float lo, float hi) { h2 v = {(_Float16)lo, (_Float16)hi}; return __builtin_bit_cast(unsigned, v); }
__device__ __forceinline__ float h2f(f16_t b) { return (float)__builtin_bit_cast(_Float16, b); }
__device__ __forceinline__ f16_t f2h(float f) { return __builtin_bit_cast(f16_t, (_Float16)f); }

namespace pg8 {
#define PG8_LAS __attribute__((address_space(3)))
typedef unsigned short bf16_t;
typedef _Float16 bf16x8 __attribute__((ext_vector_type(8)));
typedef float f32x4 __attribute__((ext_vector_type(4)));
typedef unsigned u32x4 __attribute__((ext_vector_type(4)));
typedef unsigned u32x2 __attribute__((ext_vector_type(2)));
constexpr int BM = 256, BK = 64, HALF = 128, HTB = HALF * BK * 2  , STAGE_BYTES = 8 * HTB, NXCD = 8, WGM = 8;

__host__ __device__ __forceinline__ int lds_byte(int r, int c) { const int st = (r >> 4) * 2 + (c >> 5), rr = r & 15, cc = c & 31, ob = rr * 64 + cc * 2; return st * 1024 + (ob ^ (((ob >> 9) & 1) << 5)); }
__host__ __device__ __forceinline__ void stage_rc(int b, int& R, int& C) { const int st = b / 1024, sb = b % 1024, swz = sb ^ (((sb >> 9) & 1) << 5); R = (st >> 1) * 16 + swz / 64; C = (st & 1) * 32 + (swz % 64) / 2; }
__host__ __device__ __forceinline__ int perm32(int rho) { const int n = rho >> 4, i = rho & 15; return 8 * (i >> 2) + 4 * n + (i & 3); }

struct Unit { int pm, pn; };
struct Gemm { const bf16_t* A; const bf16_t* Bt; int M, N, K; };

struct StaticOrder {
    int nM, nN, nwg, G, c;
    __host__ __device__ void init(int M, int N, int G_, int c_) { nM = M / BM; nN = N / BM; nwg = nM * nN; G = G_; c = c_; }
    __host__ __device__ bool next(int i, Unit& u) const {
        const long L = (long)i * G + c; if (L >= nwg) return false;
        int wgid = (int)L; { const int q = nwg / NXCD, r = nwg % NXCD, xcd = wgid % NXCD, off = wgid / NXCD; wgid = (xcd < r ? xcd * (q + 1) : r * (q + 1) + (xcd - r) * q) + off; }
        const int nig = WGM * nN, gid = wgid / nig, fm = gid * WGM, gsz = (nM - fm) < WGM ? (nM - fm) : WGM;
        u.pm = fm + ((wgid % nig) % gsz); u.pn = (wgid % nig) / gsz; return true;
    }
    __device__ __forceinline__ void a_ready(const Unit&) const {}
    __device__ __forceinline__ void done(const Unit&) const {}
};

struct EpiF32 {
    static constexpr bool PERM = false, AFTER_DRAIN = false;
    float* C; int ldc;
    __device__ __forceinline__ void operator()(const f32x4 (&acc)[2][2][4][2], const Unit& u, int wr, int wc, int fr, int fq) const {
        const int row0 = u.pm * BM + wr * 64 + fr, col0 = u.pn * BM + wc * 32 + 4 * fq;
#pragma unroll
        for (int ai = 0; ai < 2; ++ai)
#pragma unroll
            for (int m = 0; m < 4; ++m) { float* rowp = C + (size_t)(row0 + ai * HALF + m * 16) * ldc + col0;
#pragma unroll
                for (int bj = 0; bj < 2; ++bj)
#pragma unroll
                    for (int n = 0; n < 2; ++n) *(f32x4*)(rowp + bj * HALF + n * 16) = acc[ai][bj][m][n]; }
    }
};
struct EpiF16 {
    static constexpr bool PERM = true, AFTER_DRAIN = false;
    bf16_t* O; int ldc;
    __device__ __forceinline__ void operator()(const f32x4 (&acc)[2][2][4][2], const Unit& u, int wr, int wc, int fr, int fq) const {
        const int row0 = u.pm * BM + wr * 64 + fr, col0 = u.pn * BM + wc * 32 + 8 * fq;
#pragma unroll
        for (int ai = 0; ai < 2; ++ai)
#pragma unroll
            for (int m = 0; m < 4; ++m) { bf16_t* rowp = O + (size_t)(row0 + ai * HALF + m * 16) * ldc + col0;
#pragma unroll
                for (int bj = 0; bj < 2; ++bj) { const f32x4 v0 = acc[ai][bj][m][0], v1 = acc[ai][bj][m][1];
                    u32x4 w; w.x = pk_f16(v0[0], v0[1]); w.y = pk_f16(v0[2], v0[3]); w.z = pk_f16(v1[0], v1[1]); w.w = pk_f16(v1[2], v1[3]);
                    *(u32x4*)(rowp + bj * HALF) = w; } }
    }
};
struct EpiProj {
    static constexpr bool PERM = true, AFTER_DRAIN = false;
    bf16_t* P; float* gates; float* kmean;
    __device__ __forceinline__ void operator()(const f32x4 (&acc)[2][2][4][2], const Unit& u, int wr, int wc, int fr, int fq) const {
        const int row0 = u.pm * BM + wr * 64 + fr;
        if (u.pn < 13) {
            const int col0 = u.pn * BM + wc * 32 + 8 * fq;
#pragma unroll
            for (int ai = 0; ai < 2; ++ai)
#pragma unroll
                for (int m = 0; m < 4; ++m) { bf16_t* rowp = P + (size_t)(row0 + ai * HALF + m * 16) * PROJ_W + col0;
#pragma unroll
                    for (int bj = 0; bj < 2; ++bj) { const f32x4 v0 = acc[ai][bj][m][0], v1 = acc[ai][bj][m][1];
                        u32x4 w; w.x = pk_f16(v0[0], v0[1]); w.y = pk_f16(v0[2], v0[3]); w.z = pk_f16(v1[0], v1[1]); w.w = pk_f16(v1[2], v1[3]);
                        *(u32x4*)(rowp + bj * HALF) = w; } }
            if (u.pn == 3) {
                const int b = u.pm >> 5, nb = u.pm & 31;
#pragma unroll
                for (int bj = 0; bj < 2; ++bj)
#pragma unroll
                    for (int n = 0; n < 2; ++n) {
                        f32x4 s = {0.f, 0.f, 0.f, 0.f};
#pragma unroll
                        for (int ai = 0; ai < 2; ++ai)
#pragma unroll
                            for (int m = 0; m < 4; ++m) s += acc[ai][bj][m][n];
#pragma unroll
                        for (int j = 0; j < 4; ++j) s[j] = sum16(s[j]);
                        if (fr == 0) { const int c = 128 * bj + 32 * wc + 8 * fq + 4 * n, h = c >> 6, d = c & 63; float* kp = kmean + (size_t)((b * 4 + h) * 32 + nb) * 64 + d;
#pragma unroll
                            for (int j = 0; j < 4; ++j) atomicAdd(kp + j, s[j] * (1.0f / 256.0f)); }
                    }
            }
        } else if (wc == 0 && fq == 0) {
#pragma unroll
            for (int ai = 0; ai < 2; ++ai)
#pragma unroll
                for (int m = 0; m < 4; ++m) { float* gp = gates + (size_t)(row0 + ai * HALF + m * 16) * 8;
                    *(f32x4*)gp = acc[ai][0][m][0]; *(f32x4*)(gp + 4) = acc[ai][0][m][1]; }
        }
    }
};

__device__ __forceinline__ float dpp_shr1(float old, float src) { return __builtin_bit_cast(float, __builtin_amdgcn_update_dpp(__builtin_bit_cast(int, old), __builtin_bit_cast(int, src), 0x111, 0xf, 0xf, false)); }
__device__ __forceinline__ float dpp_shr2(float old, float src) { return __builtin_bit_cast(float, __builtin_amdgcn_update_dpp(__builtin_bit_cast(int, old), __builtin_bit_cast(int, src), 0x112, 0xf, 0xf, false)); }
__device__ __forceinline__ float dpp_ror1(float src) { return __builtin_bit_cast(float, __builtin_amdgcn_update_dpp(0, __builtin_bit_cast(int, src), 0x121, 0xf, 0xf, false)); }
__device__ __forceinline__ float dpp_ror2(float src) { return __builtin_bit_cast(float, __builtin_amdgcn_update_dpp(0, __builtin_bit_cast(int, src), 0x122, 0xf, 0xf, false)); }
__device__ __forceinline__ float geglu_f(float g, float u) {
    const float t = g * fmaf(g * g, 0.10294326f, 2.3022082f);
    return g * u * __builtin_amdgcn_rcpf(1.f + __builtin_amdgcn_exp2f(-t));
}
struct EpiGlu {
    static constexpr bool PERM = true, AFTER_DRAIN = false;
    bf16_t* ACT; float* HALO; const float* cw; const float* cb;
    __device__ __forceinline__ void operator()(const f32x4 (&acc)[2][2][4][2], const Unit& u, int wr, int wc, int fr, int fq) const {
        const int j0 = u.pn * 128 + wc * 32 + 8 * fq;
        const int strip = 2 * u.pm + wr;
#pragma unroll
        for (int n = 0; n < 2; ++n) {
            const int cg = j0 + 4 * n, cu = D_FF + j0 + 4 * n;
            const f32x4 wg0 = *(const f32x4*)(cw + cg), wg1 = *(const f32x4*)(cw + 2 * D_FF + cg), wg2 = *(const f32x4*)(cw + 4 * D_FF + cg), bg = *(const f32x4*)(cb + cg);
            const f32x4 wu0 = *(const f32x4*)(cw + cu), wu1 = *(const f32x4*)(cw + 2 * D_FF + cu), wu2 = *(const f32x4*)(cw + 4 * D_FF + cu), bu = *(const f32x4*)(cb + cu);
            f32x4 g1 = {0.f, 0.f, 0.f, 0.f}, g2 = g1, u1 = g1, u2 = g1;
            unsigned acto = (unsigned)(strip * 128 + fr) * D_FF + cg;
#pragma unroll
            for (int q = 0; q < 8; ++q) {
                const f32x4 curg = acc[q >> 2][0][q & 3][n], curu = acc[q >> 2][1][q & 3][n];
                if ((q == 0 && fr < 2) || (q == 7 && fr >= 14)) {
                    unsigned ho = (unsigned)(strip * 4 + (q == 0 ? fr : fr - 12)) * (2 * D_FF) + cg; asm volatile("" : "+v"(ho));
                    *(f32x4*)(HALO + ho) = curg; *(f32x4*)(HALO + ho + D_FF) = curu; }
                float o[4];
#pragma unroll
                for (int e = 0; e < 4; ++e) {
                    const float yg = fmaf(wg2[e], curg[e], fmaf(wg1[e], dpp_shr1(g1[e], curg[e]), fmaf(wg0[e], dpp_shr2(g2[e], curg[e]), bg[e])));
                    const float yu = fmaf(wu2[e], curu[e], fmaf(wu1[e], dpp_shr1(u1[e], curu[e]), fmaf(wu0[e], dpp_shr2(u2[e], curu[e]), bu[e])));
                    o[e] = geglu_f(yg, yu);
                }
#pragma unroll
                for (int e = 0; e < 4; ++e) { g1[e] = dpp_ror1(curg[e]); g2[e] = dpp_ror2(curg[e]); u1[e] = dpp_ror1(curu[e]); u2[e] = dpp_ror2(curu[e]); }
                u32x2 w; w.x = pk_f16(o[0], o[1]); w.y = pk_f16(o[2], o[3]);
                if (!(q == 0 && fr < 2)) *(u32x2*)(ACT + acto) = w;
                acto += 16 * D_FF; asm volatile("" : "+v"(acto));
            }
        }
    }
};

template <class Epi, class Sched, bool ALIGN_EPI = false, bool SP2 = false, bool APERM = false>
__device__ __forceinline__ void gemm_phase(PG8_LAS unsigned char* lds, const Gemm g, const Sched& S, const Epi& E, int tid_in) {
    int tid_ = tid_in; asm volatile("" : "+v"(tid_));
    const int tid = tid_, wid = __builtin_amdgcn_readfirstlane(tid >> 6), lane = tid & 63, wr = wid >> 2, wc = wid & 3, fr = lane & 15, fq = lane >> 4;
    const int K = g.K, nt = K / BK;
    unsigned voffA[2], voffB[2];
#pragma unroll
    for (int i = 0; i < 2; ++i) { int R, C; stage_rc(tid * 16 + i * 8192, R, C); const int Rb = Epi::PERM ? ((R & ~31) + perm32(R & 31)) : R;
        const int Ra = APERM ? (128 * (R >> 6) + (R & 63)) : R;
        voffA[i] = (unsigned)(Ra * K + C) * 2u; voffB[i] = (unsigned)(Rb * K + C) * 2u; }
    const size_t kstep = (size_t)(BK * 2);
    const size_t hstep = (size_t)HALF * K * 2;
    const size_t hstepA = APERM ? (size_t)64 * K * 2 : hstep;
    const size_t tstep = 2 * hstep;
    const unsigned ldsw = (unsigned)wid * 1024u;
    const int aoff = lds_byte(wr * 64 + fr, fq * 8), boff = lds_byte(wc * 32 + fr, fq * 8);
#define PG8_SA(b, h) (((b) * 2 + (h)) * HTB)
#define PG8_SB(b, h) ((4 + (b) * 2 + (h)) * HTB)
#define PG8_STAGE(bufoff, gbase, voff) do { _Pragma("unroll") for (int _i = 0; _i < 2; ++_i) \
        __builtin_amdgcn_global_load_lds((const unsigned*)((const char*)(gbase) + (voff)[_i]), (PG8_LAS unsigned*)(lds + (bufoff) + ldsw + _i * 8192), 16, 0, 0); } while (0)
#define PG8_LDA(dst, b, h) do { _Pragma("unroll") for (int m = 0; m < 4; ++m) _Pragma("unroll") for (int k = 0; k < 2; ++k) dst[m][k] = *(const PG8_LAS bf16x8*)(lds + PG8_SA(b, h) + aoff + m * 2048 + k * 1024); } while (0)
#define PG8_LDB(dst, b, h) do { _Pragma("unroll") for (int n = 0; n < 2; ++n) _Pragma("unroll") for (int k = 0; k < 2; ++k) dst[n][k] = *(const PG8_LAS bf16x8*)(lds + PG8_SB(b, h) + boff + n * 2048 + k * 1024); } while (0)
#define PG8_MMA(ai, bj, At, Bt) do { __builtin_amdgcn_s_setprio(1); _Pragma("unroll") for (int m = 0; m < 4; ++m) _Pragma("unroll") for (int n = 0; n < 2; ++n) _Pragma("unroll") for (int k = 0; k < 2; ++k) \
        acc[ai][bj][m][n] = __builtin_amdgcn_mfma_f32_16x16x32_f16(Bt[n][k], At[m][k], acc[ai][bj][m][n], 0, 0, 0); __builtin_amdgcn_s_setprio(0); } while (0)
#define PG8_WAIT_V(n) asm volatile("s_waitcnt vmcnt(" #n ")" ::: "memory")
#define PG8_WAIT_L(n) asm volatile("s_waitcnt lgkmcnt(" #n ")" ::: "memory")
#define PG8_BAR __builtin_amdgcn_s_barrier()
#define PG8_SCHED __builtin_amdgcn_sched_barrier(0)
    Unit cur, nxt; int ui = 0;
    if (!S.next(0, cur)) return;
    f32x4 acc[2][2][4][2];
#pragma unroll
    for (int a = 0; a < 2; ++a)
#pragma unroll
        for (int b = 0; b < 2; ++b)
#pragma unroll
            for (int m = 0; m < 4; ++m)
#pragma unroll
                for (int n = 0; n < 2; ++n) acc[a][b][m][n] = (f32x4){0.f, 0.f, 0.f, 0.f};
    bf16x8 At[4][2], B0[2][2], B1[2][2];
    const char* cA = (const char*)g.A + (size_t)cur.pm * tstep; const char* cB = (const char*)g.Bt + (size_t)cur.pn * tstep;
    S.a_ready(cur);
    if constexpr (SP2) {
        PG8_STAGE(PG8_SB(0, 0), cB, voffB); PG8_STAGE(PG8_SB(0, 1), cB + hstep, voffB); PG8_STAGE(PG8_SA(0, 0), cA, voffA); PG8_STAGE(PG8_SA(0, 1), cA + hstepA, voffA);
        if (wr == 1) PG8_BAR;
        PG8_WAIT_V(2); PG8_BAR;
        PG8_STAGE(PG8_SB(1, 0), cB + kstep, voffB); PG8_STAGE(PG8_SA(1, 0), cA + kstep, voffA); PG8_STAGE(PG8_SB(1, 1), cB + hstep + kstep, voffB);
        PG8_WAIT_V(6); PG8_BAR;
    } else {
        PG8_STAGE(PG8_SB(0, 0), cB, voffB); PG8_STAGE(PG8_SA(0, 0), cA, voffA); PG8_STAGE(PG8_SB(0, 1), cB + hstep, voffB); PG8_STAGE(PG8_SA(0, 1), cA + hstepA, voffA);
        if (wr == 1) PG8_BAR;
        PG8_WAIT_V(4); PG8_BAR;
        PG8_STAGE(PG8_SB(1, 0), cB + kstep, voffB); PG8_STAGE(PG8_SA(1, 0), cA + kstep, voffA); PG8_STAGE(PG8_SB(1, 1), cB + hstep + kstep, voffB);
        PG8_WAIT_V(6); PG8_BAR;
    }
    for (;;) {
        const bool has_next = S.next(ui + 1, nxt);
        const char* nA = has_next ? (const char*)g.A + (size_t)nxt.pm * tstep : cA; const char* nB = has_next ? (const char*)g.Bt + (size_t)nxt.pn * tstep : cB;
        for (int t = 0; t < nt; t += 2) {
            const bool last = (t == nt - 2);
            const char* a1 = cA + (size_t)(t + 1) * kstep;
            const char* a2 = last ? nA : cA + (size_t)(t + 2) * kstep; const char* b2 = last ? nB : cB + (size_t)(t + 2) * kstep;
            const char* a3 = a2 + kstep; const char* b3 = b2 + kstep;
            if (last && has_next) S.a_ready(nxt);
            if constexpr (SP2) {
            PG8_LDB(B0, 0, 0); PG8_LDB(B1, 0, 1); PG8_SCHED; PG8_LDA(At, 0, 0); PG8_STAGE(PG8_SA(1, 1), a1 + hstepA, voffA);
            PG8_WAIT_V(8); PG8_WAIT_L(0); PG8_BAR; PG8_MMA(0, 0, At, B0); PG8_MMA(0, 1, At, B1); PG8_BAR; PG8_SCHED;
            PG8_LDA(At, 0, 1); PG8_STAGE(PG8_SB(0, 0), b2, voffB); PG8_STAGE(PG8_SB(0, 1), b2 + hstep, voffB); PG8_STAGE(PG8_SA(0, 0), a2, voffA);
            PG8_WAIT_V(8); PG8_WAIT_L(0); PG8_BAR; PG8_MMA(1, 0, At, B0); PG8_MMA(1, 1, At, B1); PG8_BAR; PG8_SCHED;
            PG8_LDB(B0, 1, 0); PG8_LDB(B1, 1, 1); PG8_SCHED; PG8_LDA(At, 1, 0); PG8_STAGE(PG8_SA(0, 1), a2 + hstepA, voffA);
            PG8_WAIT_V(8); PG8_WAIT_L(0); PG8_BAR; PG8_MMA(0, 0, At, B0); PG8_MMA(0, 1, At, B1); PG8_BAR; PG8_SCHED;
            PG8_LDA(At, 1, 1); PG8_STAGE(PG8_SB(1, 0), b3, voffB); PG8_STAGE(PG8_SB(1, 1), b3 + hstep, voffB); PG8_STAGE(PG8_SA(1, 0), a3, voffA);
            PG8_WAIT_V(8); PG8_WAIT_L(0); PG8_BAR; PG8_MMA(1, 0, At, B0); PG8_MMA(1, 1, At, B1); PG8_BAR; PG8_SCHED;
            } else {
            PG8_LDB(B0, 0, 0); PG8_SCHED; PG8_LDA(At, 0, 0); PG8_STAGE(PG8_SA(1, 1), a1 + hstepA, voffA);
            PG8_WAIT_L(8); PG8_BAR; PG8_WAIT_L(0); PG8_MMA(0, 0, At, B0); PG8_BAR; PG8_SCHED;
            PG8_LDB(B1, 0, 1); PG8_STAGE(PG8_SB(0, 0), b2, voffB);
            PG8_BAR; PG8_WAIT_L(0); PG8_MMA(0, 1, At, B1); PG8_BAR;
            PG8_LDA(At, 0, 1); PG8_STAGE(PG8_SA(0, 0), a2, voffA);
            PG8_BAR; PG8_WAIT_L(0); PG8_MMA(1, 0, At, B0); PG8_BAR; PG8_SCHED;
            PG8_STAGE(PG8_SB(0, 1), b2 + hstep, voffB);
            PG8_WAIT_V(6); PG8_BAR; PG8_MMA(1, 1, At, B1); PG8_BAR;
            PG8_LDB(B0, 1, 0); PG8_SCHED; PG8_LDA(At, 1, 0); PG8_STAGE(PG8_SA(0, 1), a2 + hstepA, voffA);
            PG8_WAIT_L(8); PG8_BAR; PG8_WAIT_L(0); PG8_MMA(0, 0, At, B0); PG8_BAR; PG8_SCHED;
            PG8_LDB(B1, 1, 1); PG8_STAGE(PG8_SB(1, 0), b3, voffB);
            PG8_BAR; PG8_WAIT_L(0); PG8_MMA(0, 1, At, B1); PG8_BAR;
            PG8_LDA(At, 1, 1); PG8_STAGE(PG8_SA(1, 0), a3, voffA);
            PG8_BAR; PG8_WAIT_L(0); PG8_MMA(1, 0, At, B0); PG8_BAR; PG8_SCHED;
            PG8_STAGE(PG8_SB(1, 1), b3 + hstep, voffB);
            PG8_WAIT_V(6); PG8_BAR; PG8_MMA(1, 1, At, B1); PG8_BAR;
            }
        }
        if constexpr (ALIGN_EPI) { if (wr == 0) PG8_BAR; }
        if constexpr (!Epi::AFTER_DRAIN) { const int le_ = lane_id_volatile(); const int fr_ = le_ & 15, fq_ = le_ >> 4;
            E(acc, cur, wr, wc, fr_, fq_); S.done(cur); }
        if (!has_next) break;
#pragma unroll
        for (int a = 0; a < 2; ++a)
#pragma unroll
            for (int b = 0; b < 2; ++b)
#pragma unroll
                for (int m = 0; m < 4; ++m)
#pragma unroll
                    for (int n = 0; n < 2; ++n) acc[a][b][m][n] = (f32x4){0.f, 0.f, 0.f, 0.f};
        cur = nxt; cA = nA; cB = nB; ++ui;
        if constexpr (ALIGN_EPI) { if (wr == 1) PG8_BAR; }
    }
    PG8_WAIT_V(0);
    if constexpr (!ALIGN_EPI) { if (wr == 0) PG8_BAR; }
    PG8_BAR;
    if constexpr (Epi::AFTER_DRAIN) { E.fused(acc, cur, wr, wc, fr, fq, lds, wid, lane); S.done(cur); }
#undef PG8_SA
#undef PG8_SB
#undef PG8_STAGE
#undef PG8_LDA
#undef PG8_LDB
#undef PG8_MMA
#undef PG8_WAIT_V
#undef PG8_WAIT_L
#undef PG8_BAR
#undef PG8_SCHED
}
}
#define GAS __attribute__((address_space(1)))
#define LAS __attribute__((address_space(3)))
typedef GAS unsigned gu32;
typedef GAS unsigned long long gu64;
#define RLX_AGENT __ATOMIC_RELAXED, __HIP_MEMORY_SCOPE_AGENT
#define LDS_WAIT() asm volatile("s_waitcnt lgkmcnt(0)" ::: "memory")
#define VM_WAIT() asm volatile("s_waitcnt vmcnt(0)" ::: "memory")
#define XB_TMO      128
#define XB_XCNT(j)  (256  + 64 * (j))
#define XB_XSUB(j)  (1280 + 64 * (j))
#define XB_XGEN(j)  (2304 + 64 * (j))
#define XB_TOP      3328
#define XB_TOPGEN   3392
#define XCD_BAR_WORDS 3456
#define XB_SPIN_CAP (1u << 18)

__device__ __forceinline__ unsigned xb_ld(unsigned* p)              { return __hip_atomic_load(p, __ATOMIC_RELAXED, __HIP_MEMORY_SCOPE_AGENT); }
__device__ __forceinline__ unsigned xb_add(unsigned* p, unsigned v) { return __hip_atomic_fetch_add(p, v, __ATOMIC_RELAXED, __HIP_MEMORY_SCOPE_AGENT); }
__device__ __forceinline__ unsigned xb_xcc_id() { return (unsigned)__builtin_amdgcn_s_getreg((3 << 11) | 20) & 0xFu; }
#define XB_SPIN(cond, bar) do { unsigned _sp = 0; while (cond) { __builtin_amdgcn_s_sleep(1); \
    if ((++_sp & 255u) == 0u) { if (xb_ld(&(bar)[XB_TMO])) break; if (_sp > XB_SPIN_CAP) { atomicAdd(&(bar)[XB_TMO], 1u); break; } } } } while (0)

struct XcdBarrier {
    unsigned* bar; unsigned x;
    volatile LAS unsigned* st;
};

__device__ __forceinline__ XcdBarrier xcd_barrier_post(unsigned* bar, volatile LAS unsigned* st) {
    XcdBarrier b; b.bar = bar; b.x = xb_xcc_id(); b.st = st;
    if (threadIdx.x == 0) (void)xb_add(&bar[XB_XCNT(b.x)], 1u);
    return b;
}
__device__ __forceinline__ void xcd_barrier_complete(unsigned* bar, unsigned x, unsigned& nloc, unsigned& nx) {
    const unsigned G = gridDim.x * gridDim.y * gridDim.z;
    unsigned sum, cnt, mine, sp = 0u;
    for (;;) {
        sum = 0u; cnt = 0u; mine = 0u;
#pragma unroll
        for (unsigned j = 0; j < 16; ++j) { const unsigned c = xb_ld(&bar[XB_XCNT(j)]); sum += c; cnt += (c > 0u) ? 1u : 0u; mine = (j == x) ? c : mine; }
        if (sum == G) break;
        __builtin_amdgcn_s_sleep(1);
        if ((++sp & 255u) == 0u) { if (xb_ld(&bar[XB_TMO])) break; if (sp > XB_SPIN_CAP) { atomicAdd(&bar[XB_TMO], 1u); break; } }
    }
    nloc = mine > 0u ? mine : 1u; nx = cnt > 0u ? cnt : 1u;
}

__device__ __forceinline__ void xcd_barrier(const XcdBarrier& b, bool leader_thread) {
    asm volatile("s_waitcnt vmcnt(0)" ::: "memory");
    __syncthreads();
    if (leader_thread) {
        unsigned* bar = b.bar;
        __builtin_amdgcn_s_waitcnt(0);
        unsigned nloc = b.st[0], nx = b.st[1];
        if (nloc == 0u) { xcd_barrier_complete(bar, b.x, nloc, nx); b.st[0] = nloc; b.st[1] = nx; }
        const unsigned old = xb_add(&bar[XB_XSUB(b.x)], 1u);
        const unsigned gen = old / nloc;
        if (old + 1u == (gen + 1u) * nloc) {
            __builtin_amdgcn_fence(__ATOMIC_RELEASE, "agent");
            asm volatile("s_waitcnt vmcnt(0)" ::: "memory");
            const unsigned og = xb_add(&bar[XB_TOP], 1u);
            const unsigned tg = og / nx;
            if (og + 1u == (tg + 1u) * nx) xb_add(&bar[XB_TOPGEN], 1u);
            else XB_SPIN(xb_ld(&bar[XB_TOPGEN]) == tg, bar);
            __builtin_amdgcn_fence(__ATOMIC_ACQUIRE, "agent");
            xb_add(&bar[XB_XGEN(b.x)], 1u);
            asm volatile("s_waitcnt vmcnt(0)" ::: "memory");
        } else {
            XB_SPIN(xb_ld(&bar[XB_XGEN(b.x)]) == gen, bar);
            __builtin_amdgcn_fence(__ATOMIC_ACQUIRE, "agent");
            asm volatile("s_waitcnt vmcnt(0)" ::: "memory");
        }
    }
    __syncthreads();
}

struct Args { const float* in[16]; float* out; unsigned char* ws; };

struct Frame {
    LAS unsigned char* lds;
    int tid, lane, wave, G, bid;
};

__device__ __forceinline__ float wave_sum(float v) { v = sum16(v); v += swz_xor<16>(v); auto rr = __builtin_amdgcn_permlane32_swap(__float_as_uint(v), __float_as_uint(v), false, false); return __uint_as_float(rr[0]) + __uint_as_float(rr[1]); }
__device__ __forceinline__ float softplus_f(float x) {
    const float e = __builtin_amdgcn_exp2f(x * 1.4426950408889634f);
    const float small = e * (1.f - e * (0.5f - e * (0.33333334f - 0.25f * e)));
    const float big = __builtin_amdgcn_logf(1.f + e) * 0.6931471805599453f;
    return x > 20.f ? x : (e < 0.015625f ? small : big);
}
__device__ __forceinline__ float silu_f(float x) { return x / (1.f + __expf(-x)); }
__device__ __forceinline__ float gelu_tanh_f(float x) { const float y = 0.7978845608028654f * (x + 0.044715f * x * x * x); return 0.5f * x * (1.f + tanhf(y)); }
__device__ __forceinline__ void ld8(const f16_t* p, float (&o)[8]) { const h8 v = *(const h8*)p;
#pragma unroll
    for (int j = 0; j < 8; ++j) o[j] = (float)v[j]; }

__device__ __forceinline__ void transpose_item(const float* W, int K, int ldw, f16_t* WT, int k0, int dr0, int sc0, int valid, LAS float* scr, int lane) {
    const bool ok = (lane & 31) < valid;
#pragma unroll 8
    for (int i = 0; i < 32; ++i) { const int kk = 2 * i + (lane >> 5); scr[kk * 33 + (lane & 31)] = ok ? W[(size_t)(k0 + kk) * ldw + sc0 + (lane & 31)] : 0.f; }
    LDS_WAIT(); asm volatile("" ::: "memory");
    const int c = lane & 7;
#pragma unroll
    for (int j = 0; j < 4; ++j) { const int n = (lane >> 3) + 8 * j; const LAS float* s = scr + (8 * c) * 33 + n;
        uint4 o; o.x = pk_f16(s[0 * 33], s[1 * 33]); o.y = pk_f16(s[2 * 33], s[3 * 33]); o.z = pk_f16(s[4 * 33], s[5 * 33]); o.w = pk_f16(s[6 * 33], s[7 * 33]);
        *(uint4*)(WT + (size_t)(dr0 + n) * K + k0 + 8 * c) = o; }
    LDS_WAIT(); asm volatile("" ::: "memory");
}
__device__ __forceinline__ void rms_row_to_f16(const float* xrow, const float* w, f16_t* orow, int lane) {
    const float4* xr = (const float4*)xrow + lane; const float4* wr = (const float4*)w + lane;
    float4 v[4]; float s = 0.f;
#pragma unroll
    for (int j = 0; j < 4; ++j) { v[j] = xr[64 * j]; s += (v[j].x * v[j].x + v[j].y * v[j].y) + (v[j].z * v[j].z + v[j].w * v[j].w); }
    const float r = rsqrtf(wave_sum(s) * (1.f / D_MODEL) + NORM_EPS);
    uint2* o8 = (uint2*)orow + lane;
#pragma unroll
    for (int j = 0; j < 4; ++j) { const float4 ww = wr[64 * j]; uint2 o; o.x = pk_f16(v[j].x * r * ww.x, v[j].y * r * ww.y); o.y = pk_f16(v[j].z * r * ww.z, v[j].w * r * ww.w); o8[64 * j] = o; }
}
__device__ __forceinline__ void p0_prologue(const Frame& F, const Args& a) {
    LAS float* scr = (LAS float*)(F.lds + RING_OFF + F.wave * 16384);
    const int gw = F.bid * NWAVES + F.wave, NGW = F.G * NWAVES;
    constexpr int I_IN = 16 * (IN_PAD / 32), I_OUT = 16 * 32, I_UP = 16 * (2 * D_FF / 32), I_DOWN = (D_FF / 64) * 32, I_L = I_IN + I_OUT + I_UP + I_DOWN;
    for (int it = gw; it < DEPTH * I_L; it += NGW) {
        const int l = it / I_L; int r = it % I_L;
        unsigned char* wb = a.ws + WS_W + (size_t)l * W_LAYER;
        if (r < I_IN) { const int kb = r / (IN_PAD / 32), nb = r % (IN_PAD / 32); int valid = IN_WIDTH - 32 * nb; valid = valid < 0 ? 0 : (valid > 32 ? 32 : valid);
            transpose_item(a.in[2] + (size_t)l * D_MODEL * IN_WIDTH, D_MODEL, IN_WIDTH, (f16_t*)(wb + W_IN), 64 * kb, 32 * nb, 32 * nb, valid, scr, F.lane); continue; }
        r -= I_IN;
        if (r < I_OUT) { const int kb = r / 32, nb = r % 32;
            transpose_item(a.in[8] + (size_t)l * D_MODEL * D_MODEL, D_MODEL, D_MODEL, (f16_t*)(wb + W_OUT), 64 * kb, 32 * nb, 32 * nb, 32, scr, F.lane); continue; }
        r -= I_OUT;
        if (r < I_UP) { const int kb = r / (2 * D_FF / 32), nb = r % (2 * D_FF / 32); const int r0 = 32 * nb, tj = r0 >> 8, half = (r0 >> 7) & 1, i0 = r0 & 127;
            transpose_item(a.in[11] + (size_t)l * D_MODEL * 2 * D_FF, D_MODEL, 2 * D_FF, (f16_t*)(wb + W_UP), 64 * kb, r0, half * D_FF + 128 * tj + i0, 32, scr, F.lane); continue; }
        r -= I_UP;
        { const int kb = r / 32, nb = r % 32;
            transpose_item(a.in[14] + (size_t)l * D_FF * D_MODEL, D_FF, D_MODEL, (f16_t*)(wb + W_DOWN), 64 * kb, 32 * nb, 32 * nb, 32, scr, F.lane); }
    }
    f16_t* XN = (f16_t*)(a.ws + WS_XN);
    for (int m = gw; m < T_TOK; m += NGW) rms_row_to_f16(a.in[0] + (size_t)m * D_MODEL, a.in[1], XN + (size_t)m * D_MODEL, F.lane);
}

__device__ __forceinline__ void naive_add_norm(const Frame& F, const float* xin, const float* y, const float* w, float* xout, const float* w2, f16_t* xn) {
    const int gw = F.bid * NWAVES + F.wave, NGW = F.G * NWAVES;
    for (int m = gw; m < T_TOK; m += NGW) {
        const float4* yr = (const float4*)(y + (size_t)m * D_MODEL) + F.lane; const float4* xr = (const float4*)(xin + (size_t)m * D_MODEL) + F.lane; const float4* wr = (const float4*)w + F.lane;
        float4 v[4]; float s = 0.f;
#pragma unroll
        for (int j = 0; j < 4; ++j) { v[j] = yr[64 * j]; s += (v[j].x * v[j].x + v[j].y * v[j].y) + (v[j].z * v[j].z + v[j].w * v[j].w); }
        const float r = rsqrtf(wave_sum(s) * (1.f / D_MODEL) + NORM_EPS);
        float4* orow = (float4*)(xout + (size_t)m * D_MODEL) + F.lane; float s2 = 0.f;
#pragma unroll
        for (int j = 0; j < 4; ++j) { const float4 ww = wr[64 * j], xx = xr[64 * j]; float4 o; o.x = xx.x + v[j].x * r * ww.x; o.y = xx.y + v[j].y * r * ww.y; o.z = xx.z + v[j].z * r * ww.z; o.w = xx.w + v[j].w * r * ww.w;
            orow[64 * j] = o; v[j] = o; s2 += (o.x * o.x + o.y * o.y) + (o.z * o.z + o.w * o.w); }
        if (xn) {
            const float r2 = rsqrtf(wave_sum(s2) * (1.f / D_MODEL) + NORM_EPS);
            const float4* w2r = (const float4*)w2 + F.lane; uint2* o8 = (uint2*)(xn + (size_t)m * D_MODEL) + F.lane;
#pragma unroll
            for (int j = 0; j < 4; ++j) { const float4 ww = w2r[64 * j]; uint2 o; o.x = pk_f16(v[j].x * r2 * ww.x, v[j].y * r2 * ww.y); o.y = pk_f16(v[j].z * r2 * ww.z, v[j].w * r2 * ww.w); o8[64 * j] = o; }
        }
    }
}
constexpr int DNI_CHUNK = 73728, DNI_NEGW = 0, DNI_QD = 16384, DNI_KDT = 32768, DNI_A = 49152, DNI_UT = 57344, DNI_STAGE = 57344;
constexpr size_t WS_EGL = 2 * MiB + 512 * 1024;
__device__ __forceinline__ int perm64(int j) { const int rem = j & 31; return (j & ~31) + 8 * ((rem >> 2) & 3) + 4 * (rem >> 4) + (rem & 3); }
__device__ __forceinline__ int imgW_b(int i, int dp) { return i * 256 + ((((dp >> 3) ^ (i & 15))) << 4) + (dp & 7) * 2; }
__device__ __forceinline__ int imgK_b(int row, int cp) { return (row >> 1) * 256 + (((((row & 1) << 3) | (cp >> 3)) ^ ((row >> 1) & 7)) << 4) + (cp & 7) * 2; }
typedef float f32x4 __attribute__((ext_vector_type(4)));
typedef unsigned u32x4v __attribute__((ext_vector_type(4)));
typedef unsigned u32x2v __attribute__((ext_vector_type(2)));

constexpr int PREP_HALF_LDS = 69632, PREP_ROWB = 272;
static_assert(2 * PREP_HALF_LDS <= LDSCTL_OFF, "prep LDS");
__device__ __forceinline__ void dn_prep(const Frame& F, const f16_t* proj, const float* gates, const float* cw, const float* a_log, const float* dt_bias, unsigned char* dni, float* egl) {
    const int half = F.tid >> 8, th0 = F.tid & 255;
    LAS unsigned char* base = F.lds + half * PREP_HALF_LDS;
    LAS unsigned char* Qh = base; LAS unsigned char* Kh = base + 17408; LAS unsigned char* Vh = base + 34816;
    LAS float* Lm = (LAS float*)(base + 52224); LAS float* sbeta = (LAS float*)(base + 68608); LAS float* sG = sbeta + 64; LAS float* seG = sbeta + 128;
    for (int pass = F.bid; pass < 1024; pass += F.G) {
        int th = th0; asm volatile("" : "+v"(th));
        const int lane = th & 63, fr = lane & 15, fq = lane >> 4, wq = th >> 6;
        const int item = 2 * pass + half, bc = item >> 2, h = item & 3, b = bc >> 7, c = bc & 127, t0 = c * 64;
        const size_t row0 = (size_t)b * SEQ + t0;
        unsigned char* out = dni + (size_t)((b * 4 + h) * 128 + c) * DNI_CHUNK;
#pragma unroll 1
        for (int j = 0; j < 12; ++j) {
            const int m = j >> 2, i = (th >> 4) + 16 * (j & 3), cg = th & 15, cc = m * 512 + h * 128 + 8 * cg;
            float acc[8];
#pragma unroll
            for (int e = 0; e < 8; ++e) acc[e] = 0.f;
#pragma unroll
            for (int tap = 0; tap < 4; ++tap) {
                if (t0 + i - 3 + tap >= 0) {
                    float x[8]; ld8(proj + (row0 + i - 3 + tap) * PROJ_W + COL_QKVC + cc, x);
                    const float4 w0 = *(const float4*)(cw + tap * 1536 + cc), w1 = *(const float4*)(cw + tap * 1536 + cc + 4);
                    acc[0] = fmaf(w0.x, x[0], acc[0]); acc[1] = fmaf(w0.y, x[1], acc[1]); acc[2] = fmaf(w0.z, x[2], acc[2]); acc[3] = fmaf(w0.w, x[3], acc[3]);
                    acc[4] = fmaf(w1.x, x[4], acc[4]); acc[5] = fmaf(w1.y, x[5], acc[5]); acc[6] = fmaf(w1.z, x[6], acc[6]); acc[7] = fmaf(w1.w, x[7], acc[7]);
                }
            }
            float ss = 0.f;
#pragma unroll
            for (int e = 0; e < 8; ++e) { acc[e] = silu_f(acc[e]); ss = fmaf(acc[e], acc[e], ss); }
            ss = sum16(ss);
            float r = 1.f;
            if (m == 0) r = rsqrtf(ss + NORM_EPS) * 0.08838834764831845f; else if (m == 1) r = rsqrtf(ss + NORM_EPS);
            u32x4v o; o.x = pk_f16(acc[0] * r, acc[1] * r); o.y = pk_f16(acc[2] * r, acc[3] * r); o.z = pk_f16(acc[4] * r, acc[5] * r); o.w = pk_f16(acc[6] * r, acc[7] * r);
            *(LAS u32x4v*)(base + m * 17408 + i * PREP_ROWB + cg * 16) = o;
        }
        if (th < 64) {
            const size_t bt = row0 + th;
            const float bcv = gates[bt * 8 + h], ac = gates[bt * 8 + 4 + h] + dt_bias[h];
            const float be = 1.f / (1.f + __expf(-bcv));
            float gs = -__expf(a_log[h]) * softplus_f(ac);
#pragma unroll
            for (int o = 1; o < 64; o <<= 1) { const float up = __builtin_bit_cast(float, __builtin_amdgcn_ds_bpermute((lane - o) << 2, __builtin_bit_cast(int, gs))); if (lane >= o) gs += up; }
            sbeta[th] = be; sG[th] = gs; seG[th] = __expf(gs);
        }
        __syncthreads();
        {
            const int mt = wq;
            h8 Ak[4], Aq[4];
#pragma unroll
            for (int s = 0; s < 4; ++s) { Ak[s] = *(const LAS h8*)(Kh + (16 * mt + fr) * PREP_ROWB + (32 * s + 8 * fq) * 2); Aq[s] = *(const LAS h8*)(Qh + (16 * mt + fr) * PREP_ROWB + (32 * s + 8 * fq) * 2); }
#pragma unroll
            for (int nt = 0; nt < 4; ++nt) {
                f32x4 kk = {0.f, 0.f, 0.f, 0.f}, qk = {0.f, 0.f, 0.f, 0.f};
#pragma unroll
                for (int s = 0; s < 4; ++s) { const h8 Bk = *(const LAS h8*)(Kh + (16 * nt + fr) * PREP_ROWB + (32 * s + 8 * fq) * 2);
                    kk = __builtin_amdgcn_mfma_f32_16x16x32_f16(Ak[s], Bk, kk, 0, 0, 0); qk = __builtin_amdgcn_mfma_f32_16x16x32_f16(Aq[s], Bk, qk, 0, 0, 0); }
                const int jc = 16 * nt + fr; const float Gj = sG[jc];
#pragma unroll
                for (int r = 0; r < 4; ++r) { const int i = 16 * mt + 4 * fq + r; const float dec = __expf(sG[i] - Gj);
                    Lm[i * 64 + jc] = (jc < i) ? sbeta[i] * kk[r] * dec : 0.f;
                    *(f16_t*)(out + DNI_A + imgK_b(i, perm64(jc))) = f2h((jc <= i) ? qk[r] * dec : 0.f); }
            }
        }
        __syncthreads();
        {
            float x[64];
            const bool isU = th < 128; const int cidx = th & 127;
            const LAS unsigned char* src = (isU ? Vh : Kh) + cidx * 2;
#pragma unroll
            for (int i = 0; i < 64; ++i) {
                const float eGi = seG[i]; const float rv = h2f(*(const LAS f16_t*)(src + i * PREP_ROWB)) * sbeta[i] * (isU ? 1.f : eGi);
                float a0 = rv, a1 = 0.f, a2 = 0.f, a3 = 0.f;
#pragma unroll
                for (int j4 = 0; j4 < (i + 3) / 4; ++j4) { const f32x4 lv = *(const LAS f32x4*)(Lm + i * 64 + 4 * j4);
                    if (4 * j4 + 0 < i) a0 = fmaf(-lv.x, x[4 * j4 + 0], a0); if (4 * j4 + 1 < i) a1 = fmaf(-lv.y, x[4 * j4 + 1], a1);
                    if (4 * j4 + 2 < i) a2 = fmaf(-lv.z, x[4 * j4 + 2], a2); if (4 * j4 + 3 < i) a3 = fmaf(-lv.w, x[4 * j4 + 3], a3); }
                x[i] = (a0 + a1) + (a2 + a3);
                asm volatile("" ::: "memory");
            }
            if (isU) {
                u32x4v* up = (u32x4v*)(out + DNI_UT + cidx * 128);
#pragma unroll
                for (int q8 = 0; q8 < 8; ++q8) { u32x4v o; o.x = pk_f16(x[8 * q8], x[8 * q8 + 1]); o.y = pk_f16(x[8 * q8 + 2], x[8 * q8 + 3]); o.z = pk_f16(x[8 * q8 + 4], x[8 * q8 + 5]); o.w = pk_f16(x[8 * q8 + 6], x[8 * q8 + 7]); up[q8] = o; }
            } else {
                const int dp = perm64(cidx);
#pragma unroll
                for (int i = 0; i < 64; ++i) *(f16_t*)(out + DNI_NEGW + imgW_b(i, dp)) = f2h(-x[i]);
            }
        }
#pragma unroll
        for (int j = 0; j < 4; ++j) {
            const int i = (th >> 4) + 16 * j, cg = th & 15; const float sc = seG[i];
            const h8 qv = *(const LAS h8*)(Qh + i * PREP_ROWB + cg * 16);
            const int s32 = (cg >> 2) * 32, jh = (cg & 3) >> 1;
            u32x2v lo, hi; lo.x = pk_f16((float)qv[0] * sc, (float)qv[1] * sc); lo.y = pk_f16((float)qv[2] * sc, (float)qv[3] * sc); hi.x = pk_f16((float)qv[4] * sc, (float)qv[5] * sc); hi.y = pk_f16((float)qv[6] * sc, (float)qv[7] * sc);
            *(u32x2v*)(out + DNI_QD + imgW_b(i, s32 + 8 * (2 * (cg & 1)) + 4 * jh)) = lo;
            *(u32x2v*)(out + DNI_QD + imgW_b(i, s32 + 8 * (2 * (cg & 1) + 1) + 4 * jh)) = hi;
        }
        {
            const int d = th & 127, ih = th >> 7; const float Gl = sG[63];
            float kv[32];
#pragma unroll
            for (int rem = 0; rem < 32; ++rem) { const int i = 32 * ih + rem; kv[8 * ((rem >> 2) & 3) + 4 * (rem >> 4) + (rem & 3)] = h2f(*(const LAS f16_t*)(Kh + i * PREP_ROWB + d * 2)) * __expf(Gl - sG[i]); }
#pragma unroll
            for (int q8 = 0; q8 < 4; ++q8) { u32x4v o; o.x = pk_f16(kv[8 * q8], kv[8 * q8 + 1]); o.y = pk_f16(kv[8 * q8 + 2], kv[8 * q8 + 3]); o.z = pk_f16(kv[8 * q8 + 4], kv[8 * q8 + 5]); o.w = pk_f16(kv[8 * q8 + 6], kv[8 * q8 + 7]);
                *(u32x4v*)(out + DNI_KDT + imgK_b(d, 32 * ih + 8 * q8)) = o; }
            if (th == 0) egl[(b * 4 + h) * 128 + c] = seG[63];
        }
        __syncthreads();
    }
}

constexpr int SCAN_PART_OFF = 2 * DNI_STAGE;
__device__ __forceinline__ void dn_scan(const Frame& F, const unsigned char* dni, const float* egl, const f16_t* proj, const float* nw, f16_t* mixed) {
    if (F.bid >= 16) return;
    const int bh = F.bid, b = bh >> 2, h = bh & 3, wv = F.wave, lane = F.lane, fr = lane & 15, fq = lane >> 4, tid = F.tid;
    const unsigned char* src = dni + (size_t)(bh * 128) * DNI_CHUNK;
    LAS unsigned char* lds = F.lds;
    f32x4 S[8];
#pragma unroll
    for (int m = 0; m < 8; ++m) S[m] = (f32x4){0.f, 0.f, 0.f, 0.f};
    u32x4v st[7]; u32x2v un[4]; f16_t zn[16]; float egn;
    const f16_t* zbase = proj + (size_t)b * SEQ * PROJ_W + COL_Z + h * 128 + 16 * wv + fr;
    const float nwe = nw[16 * wv + fr];
#define DN_LOAD(cc) do { const unsigned char* s_ = src + (size_t)(cc) * DNI_CHUNK; \
        _Pragma("unroll") for (int k = 0; k < 7; ++k) st[k] = *(const u32x4v*)(s_ + tid * 16 + 8192 * k); \
        _Pragma("unroll") for (int mt = 0; mt < 4; ++mt) un[mt] = *(const u32x2v*)(s_ + DNI_UT + (16 * wv + fr) * 128 + (16 * mt + 4 * fq) * 2); \
        _Pragma("unroll") for (int mt = 0; mt < 4; ++mt) _Pragma("unroll") for (int r = 0; r < 4; ++r) zn[4 * mt + r] = zbase[(size_t)((cc) * 64 + 16 * mt + 4 * fq + r) * PROJ_W]; \
        egn = egl[bh * 128 + (cc)]; } while (0)
    DN_LOAD(0);
#pragma unroll
    for (int k = 0; k < 7; ++k) *(LAS u32x4v*)(lds + tid * 16 + 8192 * k) = st[k];
    __syncthreads();
    f32x4 op[4]; f16_t zp[16];
#pragma unroll
    for (int mt = 0; mt < 4; ++mt) op[mt] = (f32x4){0.f, 0.f, 0.f, 0.f};
#pragma unroll
    for (int i = 0; i < 16; ++i) zp[i] = 0;
#pragma unroll 1
    for (int c = 0; c < 128; ++c) {
        LAS unsigned char* cur = lds + (c & 1) * DNI_STAGE; LAS unsigned char* nxt = lds + ((c + 1) & 1) * DNI_STAGE;
        f32x4 vn[4]; f16_t zc[16]; const float eg = egn;
#pragma unroll
        for (int mt = 0; mt < 4; ++mt) { const h4 uu = __builtin_bit_cast(h4, un[mt]); vn[mt] = (f32x4){(float)uu[0], (float)uu[1], (float)uu[2], (float)uu[3]}; }
#pragma unroll
        for (int i = 0; i < 16; ++i) zc[i] = zn[i];
        if (c + 1 < 128) DN_LOAD(c + 1);
        if (c > 0) {
            const LAS float* part = (const LAS float*)(lds + SCAN_PART_OFF + ((c - 1) & 1) * 2048);
#pragma unroll
            for (int mt = 0; mt < 4; ++mt)
#pragma unroll
                for (int r = 0; r < 4; ++r) { const int i = 16 * mt + 4 * fq + r; const f32x4 p0 = *(const LAS f32x4*)(part + i * 8), p1 = *(const LAS f32x4*)(part + i * 8 + 4);
                    const float ss = ((p0.x + p0.y) + (p0.z + p0.w)) + ((p1.x + p1.y) + (p1.z + p1.w)); const float rn = rsqrtf(ss * (1.f / 128.f) + NORM_EPS);
                    mixed[((size_t)b * SEQ + (c - 1) * 64 + i) * D_MODEL + 512 + h * 128 + 16 * wv + fr] = f2h(op[mt][r] * rn * nwe * silu_f(h2f(zp[4 * mt + r]))); }
        }
        h8 Sb[4];
#pragma unroll
        for (int s = 0; s < 4; ++s) Sb[s] = (h8){(_Float16)S[2 * s][0], (_Float16)S[2 * s][1], (_Float16)S[2 * s][2], (_Float16)S[2 * s][3], (_Float16)S[2 * s + 1][0], (_Float16)S[2 * s + 1][1], (_Float16)S[2 * s + 1][2], (_Float16)S[2 * s + 1][3]};
        f32x4 o[4];
#pragma unroll
        for (int mt = 0; mt < 4; ++mt) { const int row = 16 * mt + fr; o[mt] = (f32x4){0.f, 0.f, 0.f, 0.f};
#pragma unroll
            for (int s = 0; s < 4; ++s) { const int off = row * 256 + (((4 * s + fq) ^ (row & 15)) << 4);
                const h8 aw = *(const LAS h8*)(cur + DNI_NEGW + off), aq = *(const LAS h8*)(cur + DNI_QD + off);
                vn[mt] = __builtin_amdgcn_mfma_f32_16x16x32_f16(aw, Sb[s], vn[mt], 0, 0, 0); o[mt] = __builtin_amdgcn_mfma_f32_16x16x32_f16(aq, Sb[s], o[mt], 0, 0, 0); } }
        h8 Vb[2];
#pragma unroll
        for (int s = 0; s < 2; ++s) Vb[s] = (h8){(_Float16)vn[2 * s][0], (_Float16)vn[2 * s][1], (_Float16)vn[2 * s][2], (_Float16)vn[2 * s][3], (_Float16)vn[2 * s + 1][0], (_Float16)vn[2 * s + 1][1], (_Float16)vn[2 * s + 1][2], (_Float16)vn[2 * s + 1][3]};
#pragma unroll
        for (int mt = 0; mt < 4; ++mt) { const int row = 16 * mt + fr;
#pragma unroll
            for (int s = 0; s < 2; ++s) { const int off = (row >> 1) * 256 + (((((row & 1) << 3) | (4 * s + fq)) ^ ((row >> 1) & 7)) << 4);
                o[mt] = __builtin_amdgcn_mfma_f32_16x16x32_f16(*(const LAS h8*)(cur + DNI_A + off), Vb[s], o[mt], 0, 0, 0); } }
#pragma unroll
        for (int m = 0; m < 8; ++m) { const int row = 16 * m + fr; S[m] = S[m] * eg;
#pragma unroll
            for (int s = 0; s < 2; ++s) { const int off = (row >> 1) * 256 + (((((row & 1) << 3) | (4 * s + fq)) ^ ((row >> 1) & 7)) << 4);
                S[m] = __builtin_amdgcn_mfma_f32_16x16x32_f16(*(const LAS h8*)(cur + DNI_KDT + off), Vb[s], S[m], 0, 0, 0); } }
        {
            LAS float* part = (LAS float*)(lds + SCAN_PART_OFF + (c & 1) * 2048);
#pragma unroll
            for (int mt = 0; mt < 4; ++mt)
#pragma unroll
                for (int r = 0; r < 4; ++r) { float ss = sum16(o[mt][r] * o[mt][r]);
                    if (fr == 0) part[(16 * mt + 4 * fq + r) * 8 + wv] = ss; }
        }
        if (c + 1 < 128) {
#pragma unroll
            for (int k = 0; k < 7; ++k) *(LAS u32x4v*)(nxt + tid * 16 + 8192 * k) = st[k];
        }
#pragma unroll
        for (int mt = 0; mt < 4; ++mt) op[mt] = o[mt];
#pragma unroll
        for (int i = 0; i < 16; ++i) zp[i] = zc[i];
        __syncthreads();
    }
    {
        const LAS float* part = (const LAS float*)(lds + SCAN_PART_OFF + (127 & 1) * 2048);
#pragma unroll
        for (int mt = 0; mt < 4; ++mt)
#pragma unroll
            for (int r = 0; r < 4; ++r) { const int i = 16 * mt + 4 * fq + r; const f32x4 p0 = *(const LAS f32x4*)(part + i * 8), p1 = *(const LAS f32x4*)(part + i * 8 + 4);
                const float ss = ((p0.x + p0.y) + (p0.z + p0.w)) + ((p1.x + p1.y) + (p1.z + p1.w)); const float rn = rsqrtf(ss * (1.f / 128.f) + NORM_EPS);
                mixed[((size_t)b * SEQ + 127 * 64 + i) * D_MODEL + 512 + h * 128 + 16 * wv + fr] = f2h(op[mt][r] * rn * nwe * silu_f(h2f(zp[4 * mt + r]))); }
    }
#undef DN_LOAD
    __syncthreads();
}

typedef float f32x16 __attribute__((ext_vector_type(16)));
typedef short s16x4 __attribute__((ext_vector_type(4)));
constexpr float ATT_C2 = 0.125f * 1.4426950408889634f, LOG2E = 1.4426950408889634f, ATT_NEG = -1e30f;
constexpr int ATT_BCAST_OFF = 65536;
__device__ __forceinline__ float xhalf_max(float m) { auto rr = __builtin_amdgcn_permlane32_swap(__float_as_uint(m), __float_as_uint(m), false, false); return fmaxf(__uint_as_float(rr[0]), __uint_as_float(rr[1])); }
__device__ __forceinline__ float xhalf_sum(float m) { auto rr = __builtin_amdgcn_permlane32_swap(__float_as_uint(m), __float_as_uint(m), false, false); return __uint_as_float(rr[0]) + __uint_as_float(rr[1]); }

__device__ __forceinline__ void att_stage_tile(const f16_t* proj, long krow0, long rowmin, int kcol, int vcol, LAS unsigned char* Kt, LAS unsigned char* Vt, int tid) {
    { long r = krow0 + (tid & 63); r = r < rowmin ? rowmin : r;
      *(LAS u32x4v*)(Kt + (tid >> 6) * 1024 + (tid & 63) * 16) = *(const u32x4v*)(proj + r * PROJ_W + kcol + (tid >> 6) * 8); }
    { long r = krow0 + 16 * ((tid >> 6) & 3) + ((tid & 63) >> 2); r = r < rowmin ? rowmin : r;
      *(LAS u32x4v*)(Vt + tid * 16) = *(const u32x4v*)(proj + r * PROJ_W + vcol + 32 * (tid >> 8) + 8 * (tid & 3)); }
}
__device__ __forceinline__ void att_tile(const LAS unsigned char* Kt, const LAS unsigned char* Vt, const h8 (&qf)[4], int lane, int k0, int tq, float sl2, int W, bool rowvalid, bool posmask,
                                         float& m, float& l, f32x16& o0, f32x16& o1) {
    const int r32 = lane & 31, hi = lane >> 5;
    f32x16 p0, p1;
#pragma unroll
    for (int r = 0; r < 16; ++r) { p0[r] = 0.f; p1[r] = 0.f; }
    const LAS unsigned char* kb = Kt + hi * 1024 + r32 * 16;
#pragma unroll
    for (int d0 = 0; d0 < 4; ++d0) { const h8 b0 = *(const LAS h8*)(kb + d0 * 2048), b1 = *(const LAS h8*)(kb + d0 * 2048 + 512);
        p0 = __builtin_amdgcn_mfma_f32_32x32x16_f16(b0, qf[d0], p0, 0, 0, 0); p1 = __builtin_amdgcn_mfma_f32_32x32x16_f16(b1, qf[d0], p1, 0, 0, 0); }
    const int kq = k0 + 4 * hi - tq;
    const float c0 = sl2 * (float)kq;
    float mx = ATT_NEG;
#pragma unroll
    for (int r = 0; r < 16; ++r) { const int kr = (r & 3) + 8 * (r >> 2);
        float s0 = fmaf(p0[r], ATT_C2, fmaf(sl2, (float)kr, c0)), s1 = fmaf(p1[r], ATT_C2, fmaf(sl2, (float)(kr + 32), c0));
        bool v0 = rowvalid, v1 = rowvalid;
        if (posmask) { const int d0 = -(kq + kr), d1 = d0 - 32; v0 = v0 && d0 >= 0 && d0 < W && (tq - d0) >= 0; v1 = v1 && d1 >= 0 && d1 < W && (tq - d1) >= 0; }
        s0 = v0 ? s0 : ATT_NEG; s1 = v1 ? s1 : ATT_NEG; p0[r] = s0; p1[r] = s1; mx = fmaxf(mx, fmaxf(s0, s1)); }
    mx = xhalf_max(mx);
    const float mn = fmaxf(m, mx), alpha = __builtin_amdgcn_exp2f(m - mn);
    m = mn; l *= alpha;
#pragma unroll
    for (int r = 0; r < 16; ++r) { o0[r] *= alpha; o1[r] *= alpha; }
    float ls = 0.f;
#pragma unroll
    for (int r = 0; r < 16; ++r) { p0[r] = __builtin_amdgcn_exp2f(p0[r] - mn); p1[r] = __builtin_amdgcn_exp2f(p1[r] - mn); ls += p0[r] + p1[r]; }
    l += ls;
    h8 pa[4];
#pragma unroll
    for (int j = 0; j < 8; ++j) { pa[0][j] = (_Float16)p0[j]; pa[1][j] = (_Float16)p0[8 + j]; pa[2][j] = (_Float16)p1[j]; pa[3][j] = (_Float16)p1[8 + j]; }
    const LAS unsigned char* vb = Vt + (4 * hi + ((lane & 15) >> 2)) * 64 + ((lane >> 4) & 1) * 32 + (lane & 3) * 8;
#pragma unroll
    for (int ks = 0; ks < 4; ++ks) {
        const s16x4 l0 = __builtin_amdgcn_ds_read_tr16_b64_v4i16((LAS s16x4*)(vb + ks * 1024)), h0 = __builtin_amdgcn_ds_read_tr16_b64_v4i16((LAS s16x4*)(vb + ks * 1024 + 512));
        const s16x4 l1 = __builtin_amdgcn_ds_read_tr16_b64_v4i16((LAS s16x4*)(vb + 4096 + ks * 1024)), h1 = __builtin_amdgcn_ds_read_tr16_b64_v4i16((LAS s16x4*)(vb + 4096 + ks * 1024 + 512));
        typedef short s16x8 __attribute__((ext_vector_type(8)));
        const s16x8 a0 = {l0[0], l0[1], l0[2], l0[3], h0[0], h0[1], h0[2], h0[3]}, a1 = {l1[0], l1[1], l1[2], l1[3], h1[0], h1[1], h1[2], h1[3]};
        o0 = __builtin_amdgcn_mfma_f32_32x32x16_f16(__builtin_bit_cast(h8, a0), pa[ks], o0, 0, 0, 0);
        o1 = __builtin_amdgcn_mfma_f32_32x32x16_f16(__builtin_bit_cast(h8, a1), pa[ks], o1, 0, 0, 0);
    }
}
__device__ __forceinline__ void att_store(f16_t* orow, int hi, float l, const f32x16& o0, const f32x16& o1) {
    const float rl = 1.f / xhalf_sum(l);
#pragma unroll
    for (int g = 0; g < 4; ++g) {
        u32x2v w0, w1; w0.x = pk_f16(o0[4 * g] * rl, o0[4 * g + 1] * rl); w0.y = pk_f16(o0[4 * g + 2] * rl, o0[4 * g + 3] * rl);
        w1.x = pk_f16(o1[4 * g] * rl, o1[4 * g + 1] * rl); w1.y = pk_f16(o1[4 * g + 2] * rl, o1[4 * g + 3] * rl);
        *(u32x2v*)(orow + 8 * g + 4 * hi) = w0; *(u32x2v*)(orow + 32 + 8 * g + 4 * hi) = w1; }
}
__device__ __forceinline__ void att_load_q(const f16_t* qrow, int hi, h8 (&qf)[4]) {
#pragma unroll
    for (int d0 = 0; d0 < 4; ++d0) qf[d0] = *(const h8*)(qrow + 16 * d0 + 8 * hi);
}

__device__ __forceinline__ void swa_phase(const Frame& F, const f16_t* proj, const float* sinks, f16_t* mixed) {
    LAS unsigned char* lds = F.lds;
    const int lane = F.lane, r32 = lane & 31, hi = lane >> 5, w = F.wave;
    for (int u = F.bid; u < 512; u += F.G) {
        const int b = u >> 7, hkv = (u >> 6) & 1, blk = u & 63;
        const long rb = (long)b * SEQ; const int base = blk * 128 - 128;
        __syncthreads();
#pragma unroll
        for (int tl = 0; tl < 4; ++tl) att_stage_tile(proj, rb + base + 64 * tl, rb, COL_KA + hkv * 64, COL_VA + hkv * 64, lds + tl * 8192, lds + 32768 + tl * 8192, F.tid);
        __syncthreads();
        const int hq = 2 * hkv + (w >> 2), tq = blk * 128 + 32 * (w & 3) + r32;
        const float sl2 = exp2f(-(float)(2 * hq + 1)) * LOG2E;
        h8 qf[4]; att_load_q(proj + (rb + tq) * PROJ_W + COL_QA + hq * 64, hi, qf);
        float m = sinks[hq] * LOG2E, l = hi == 0 ? 1.f : 0.f; f32x16 o0, o1;
#pragma unroll
        for (int r = 0; r < 16; ++r) { o0[r] = 0.f; o1[r] = 0.f; }
        const int tlo = (w & 2) ? 1 : 0;
#pragma unroll 1
        for (int tl = tlo; tl < tlo + 3; ++tl) {
            if (base + 64 * tl + 63 < 0) continue;
            att_tile(lds + tl * 8192, lds + 32768 + tl * 8192, qf, lane, base + 64 * tl, tq, sl2, 128, true, true, m, l, o0, o1);
        }
        att_store(mixed + (rb + tq) * D_MODEL + hq * 64, hi, l, o0, o1);
    }
    __syncthreads();
}

__device__ __forceinline__ void moba_phase(const Frame& F, const f16_t* proj, const float* kmean, f16_t* mixed, unsigned* qctr) {
    LAS unsigned char* lds = F.lds;
    const int lane = F.lane, r32 = lane & 31, hi = lane >> 5, w = F.wave;
    volatile LAS unsigned* bc = (volatile LAS unsigned*)(lds + ATT_BCAST_OFF);
    for (;;) {
        __syncthreads();
        if (F.tid == 0) bc[0] = __hip_atomic_fetch_add(qctr, 1u, __ATOMIC_RELAXED, __HIP_MEMORY_SCOPE_AGENT);
        __syncthreads();
        const unsigned u = bc[0];
        if (u >= 512u) break;
        const int j0 = 31 - (int)(u >> 4), bh = (int)(u & 15), b = bh >> 2, h = bh & 3;
        const long rb = (long)b * SEQ;
        const int tq = 256 * j0 + 32 * w + r32;
        const float sl2 = exp2f(-(float)(2 * h + 2)) * LOG2E;
        h8 qf[4]; att_load_q(proj + (rb + tq) * PROJ_W + COL_QB + h * 64, hi, qf);
        unsigned sel = 0u;
        {
            float g0 = -3e38f, g1 = -3e38f, g2 = -3e38f; int i0 = -1, i1 = -1, i2 = -1;
            for (int n = 0; n < j0; ++n) {
                const float* kp = kmean + (size_t)((b * 4 + h) * 32 + n) * 64 + 8 * hi;
                float d = 0.f;
#pragma unroll
                for (int d0 = 0; d0 < 4; ++d0) { const float4 k0 = *(const float4*)(kp + 16 * d0), k1 = *(const float4*)(kp + 16 * d0 + 4);
                    d = fmaf((float)qf[d0][0], k0.x, d); d = fmaf((float)qf[d0][1], k0.y, d); d = fmaf((float)qf[d0][2], k0.z, d); d = fmaf((float)qf[d0][3], k0.w, d);
                    d = fmaf((float)qf[d0][4], k1.x, d); d = fmaf((float)qf[d0][5], k1.y, d); d = fmaf((float)qf[d0][6], k1.z, d); d = fmaf((float)qf[d0][7], k1.w, d); }
                d = xhalf_sum(d);
                if (d > g0) { g2 = g1; i2 = i1; g1 = g0; i1 = i0; g0 = d; i0 = n; }
                else if (d > g1) { g2 = g1; i2 = i1; g1 = d; i1 = n; }
                else if (d > g2) { g2 = d; i2 = n; }
            }
            if (i0 >= 0) sel |= 1u << i0; if (i1 >= 0) sel |= 1u << i1; if (i2 >= 0) sel |= 1u << i2;
        }
        float m = ATT_NEG, l = 0.f; f32x16 o0, o1;
#pragma unroll
        for (int r = 0; r < 16; ++r) { o0[r] = 0.f; o1[r] = 0.f; }
#pragma unroll
        for (int tl = 0; tl < 4; ++tl) att_stage_tile(proj, rb + 256 * j0 + 64 * tl, rb, COL_KB + h * 64, COL_VB + h * 64, lds + tl * 8192, lds + 32768 + tl * 8192, F.tid);
        __syncthreads();
        { const int td = w >> 1;
          att_tile(lds + td * 8192, lds + 32768 + td * 8192, qf, lane, 256 * j0 + 64 * td, tq, sl2, 1 << 30, true, true, m, l, o0, o1);
#pragma unroll 1
          for (int tl = 0; tl < td; ++tl) att_tile(lds + tl * 8192, lds + 32768 + tl * 8192, qf, lane, 256 * j0 + 64 * tl, tq, sl2, 1 << 30, true, false, m, l, o0, o1); }
#pragma unroll 1
        for (int n = j0 - 1; n >= 0; --n) {
            __syncthreads();
#pragma unroll
            for (int tl = 0; tl < 4; ++tl) att_stage_tile(proj, rb + 256 * n + 64 * tl, rb, COL_KB + h * 64, COL_VB + h * 64, lds + tl * 8192, lds + 32768 + tl * 8192, F.tid);
            __syncthreads();
            const bool mine = (sel >> n) & 1u;
            if (__any(mine)) {
#pragma unroll 1
                for (int tl = 0; tl < 4; ++tl) att_tile(lds + tl * 8192, lds + 32768 + tl * 8192, qf, lane, 256 * n + 64 * tl, tq, sl2, 1 << 30, mine, false, m, l, o0, o1);
            }
        }
        att_store(mixed + (rb + tq) * D_MODEL + 256 + h * 64, hi, l, o0, o1);
    }
    __syncthreads();
}

__device__ __forceinline__ void ffn_fixup_panel(const Frame& F, int pm, const float* HALO, const float* cw, const float* cb, f16_t* ACT) {
    for (int idx = F.tid; idx < 4 * 704; idx += NTHREADS) {
        const int rsel = idx / 704, j = (idx % 704) * 4, strip = 2 * pm + (rsel >> 1), rr = rsel & 1;
        const float* hs = HALO + (size_t)strip * 4 * (2 * D_FF); const float* hp = hs - 4 * (2 * D_FF);
        const bool has_prev = (strip & 63) != 0;
        const f32x4 z4 = {0.f, 0.f, 0.f, 0.f};
        f32x4 res[2];
#pragma unroll
        for (int bj = 0; bj < 2; ++bj) {
            const int c = bj * D_FF + j;
            const f32x4 xt = *(const f32x4*)(hs + (size_t)rr * (2 * D_FF) + c);
            const f32x4 xt1 = rr ? *(const f32x4*)(hs + c) : (has_prev ? *(const f32x4*)(hp + (size_t)3 * (2 * D_FF) + c) : z4);
            const f32x4 xt2 = has_prev ? *(const f32x4*)(hp + (size_t)(rr ? 3 : 2) * (2 * D_FF) + c) : z4;
            const f32x4 w0 = *(const f32x4*)(cw + c), w1 = *(const f32x4*)(cw + 2 * D_FF + c), w2 = *(const f32x4*)(cw + 4 * D_FF + c), bb = *(const f32x4*)(cb + c);
#pragma unroll
            for (int e = 0; e < 4; ++e) res[bj][e] = fmaf(w2[e], xt[e], fmaf(w1[e], xt1[e], fmaf(w0[e], xt2[e], bb[e])));
        }
        u32x2v w; w.x = pk_f16(pg8::geglu_f(res[0][0], res[1][0]), pg8::geglu_f(res[0][1], res[1][1])); w.y = pk_f16(pg8::geglu_f(res[0][2], res[1][2]), pg8::geglu_f(res[0][3], res[1][3]));
        *(u32x2v*)(ACT + ((size_t)strip * 128 + rr) * D_FF + j) = w;
    }
}

__global__ void __launch_bounds__(NTHREADS, 2) fwd_kernel(Args args) {
    extern __shared__ __attribute__((aligned(16))) unsigned char lds[];
    Frame F;
    F.lds = (LAS unsigned char*)lds;
    F.tid = threadIdx.x; F.lane = F.tid & 63; F.wave = __builtin_amdgcn_readfirstlane(F.tid >> 6);
    F.G = gridDim.x; F.bid = blockIdx.x;
    gu32* ctl0 = (gu32*)(args.ws + WS_CTL);
    for (int u = F.tid; u < (LDS_BYTES - LDSCTL_OFF) / 4; u += NTHREADS) ((LAS unsigned*)(F.lds + LDSCTL_OFF))[u] = 0u;
    __syncthreads();
    XcdBarrier bar = xcd_barrier_post((unsigned*)(ctl0 + CW_BAR), (volatile LAS unsigned*)(F.lds + MISC_OFF) + 8);
#define GRID_BAR() do { XcdBarrier b_ = bar; asm volatile("" : "+s"(b_.x), "+s"(b_.bar)); xcd_barrier(b_, wave0 == 0 && lane_id_volatile() == 0); } while (0)

    const int wave0 = F.wave;
    p0_prologue(F, args);
    GRID_BAR();
    constexpr int PH_PER_LAYER = 8, NPH = DEPTH * PH_PER_LAYER;
    for (int ph = 0; ph < NPH; ++ph) {
        int p = ph; asm volatile("" : "+s"(p));
#define MKF() do { int w_ = wave0; asm volatile("" : "+s"(w_)); const int l_ = lane_id_volatile(); F.wave = w_; F.lane = l_; F.tid = w_ * 64 + l_; } while (0)
        { int b_ = blockIdx.x, g_ = gridDim.x; asm volatile("" : "+s"(b_), "+s"(g_)); F.bid = b_; F.G = g_; }
        unsigned char* ws = args.ws; asm volatile("" : "+s"(ws));
        gu32* ctl = (gu32*)(ws + WS_CTL);
        f16_t* XN = (f16_t*)(ws + WS_XN); f16_t* PROJ = (f16_t*)(ws + WS_PROJ); f16_t* MIXED = (f16_t*)(ws + WS_MIXED); f16_t* ACT = (f16_t*)(ws + WS_ACT);
        float* GATES = (float*)(ws + WS_GATES); float* BETA = (float*)(ws + WS_BG); float* GG = BETA + (size_t)T_TOK * 4;
        f16_t* QKVC = (f16_t*)(ws + WS_QKVC); f16_t* OC = (f16_t*)(ws + WS_OC); float* Y1 = (float*)(ws + WS_Y1); float* Y2 = (float*)(ws + WS_Y2); f16_t* UB = (f16_t*)(ws + WS_UB);
        const int l = p / PH_PER_LAYER, k = p % PH_PER_LAYER;
        unsigned char* wb = ws + WS_W + (size_t)l * W_LAYER;
        float* kmean = (float*)(ctl + CW_KMEAN) + (size_t)l * 32768;
        if (k == 0) {
            MKF();
            pg8::Gemm g{XN, (const f16_t*)(wb + W_IN), T_TOK, IN_PAD, D_MODEL}; pg8::StaticOrder S; S.init(T_TOK, IN_PAD, F.G, F.bid);
            pg8::EpiProj E{PROJ, GATES, kmean};
            pg8::gemm_phase<pg8::EpiProj, pg8::StaticOrder, true, true>(F.lds + RING_OFF, g, S, E, F.tid);
        } else if (k == 1) {
            MKF();
            dn_prep(F, PROJ, GATES, args.in[4] + (size_t)l * 4 * 1536, args.in[5] + l * 4, args.in[6] + l * 4, ws + WS_DNI, (float*)(ws + WS_EGL));
            swa_phase(F, PROJ, args.in[3] + l * 4, MIXED);
        } else if (k == 2) {
            MKF();
            dn_scan(F, ws + WS_DNI, (const float*)(ws + WS_EGL), PROJ, args.in[7] + l * 128, MIXED);
            moba_phase(F, PROJ, kmean, MIXED, (unsigned*)(ctl + CW_QCTR + 64 * l));
        } else if (k == 3) {
            MKF();
            pg8::Gemm g{MIXED, (const f16_t*)(wb + W_OUT), T_TOK, D_MODEL, D_MODEL}; pg8::StaticOrder S; S.init(T_TOK, D_MODEL, F.G, F.bid);
            pg8::EpiF32 E{Y1, D_MODEL};
            pg8::gemm_phase<pg8::EpiF32, pg8::StaticOrder, true, true>(F.lds + RING_OFF, g, S, E, F.tid);
        } else if (k == 4) {
            MKF();
            naive_add_norm(F, l == 0 ? args.in[0] : args.out, Y1, args.in[9] + l * D_MODEL, args.out, args.in[10] + l * D_MODEL, XN);
        } else if (k == 5) {
            MKF();
            pg8::Gemm g{XN, (const f16_t*)(wb + W_UP), T_TOK, 2 * D_FF, D_MODEL}; pg8::StaticOrder S; S.init(T_TOK, 2 * D_FF, F.G, F.bid);
            pg8::EpiGlu E{ACT, (float*)(ws + WS_HALO), args.in[12] + (size_t)l * 3 * 2 * D_FF, args.in[13] + (size_t)l * 2 * D_FF};
            pg8::gemm_phase<pg8::EpiGlu, pg8::StaticOrder, true, true, true>(F.lds + RING_OFF, g, S, E, F.tid);
        } else if (k == 6) {
            MKF();
            pg8::Gemm g{ACT, (const f16_t*)(wb + W_DOWN), T_TOK, D_MODEL, D_FF}; pg8::StaticOrder S; S.init(T_TOK, D_MODEL, F.G, F.bid);
            { pg8::Unit u; for (int i = 0; S.next(i, u); ++i) ffn_fixup_panel(F, u.pm, (const float*)(ws + WS_HALO), args.in[12] + (size_t)l * 3 * 2 * D_FF, args.in[13] + (size_t)l * 2 * D_FF, ACT); }
            asm volatile("s_waitcnt vmcnt(0)" ::: "memory"); __syncthreads();
            pg8::EpiF32 E{Y2, D_MODEL};
            pg8::gemm_phase<pg8::EpiF32, pg8::StaticOrder, true, true>(F.lds + RING_OFF, g, S, E, F.tid);
        } else {
            MKF();
            naive_add_norm(F, args.out, Y2, args.in[15] + l * D_MODEL, args.out, l + 1 < DEPTH ? args.in[1] + (l + 1) * D_MODEL : nullptr, l + 1 < DEPTH ? XN : nullptr);
        }
        if (ph + 1 < NPH) GRID_BAR();
    }
}

extern "C" void kernel_launch(void* const* d_in, const int* in_sizes, int n_in, void* d_out, int out_size, void* d_ws, size_t ws_size, hipStream_t stream) {
    static int grid = 0;
    if (grid == 0) {
        if (n_in != 16 || ws_size < WS_END) { fprintf(stderr, "kernel_launch: unexpected n_in %d or ws_size %zu (< %zu)\n", n_in, ws_size, (size_t)WS_END); grid = -1; return; }
        int dev = 0, cus = 0, per_cu = 0;
        if (hipGetDevice(&dev) != hipSuccess || hipDeviceGetAttribute(&cus, hipDeviceAttributeMultiprocessorCount, dev) != hipSuccess) { grid = -1; return; }
        if (hipFuncSetAttribute((const void*)fwd_kernel, hipFuncAttributeMaxDynamicSharedMemorySize, LDS_BYTES) != hipSuccess) { fprintf(stderr, "kernel_launch: hipFuncSetAttribute failed\n"); grid = -1; return; }
        if (hipOccupancyMaxActiveBlocksPerMultiprocessor(&per_cu, (const void*)fwd_kernel, NTHREADS, LDS_BYTES) != hipSuccess || per_cu < 1) { fprintf(stderr, "kernel_launch: occupancy query failed (%d)\n", per_cu); (void)hipGetLastError(); per_cu = 1; }
        grid = cus * 1;
        if (per_cu < 1) grid = -1;
    }
    if (grid < 0) return;
    if (hipMemsetAsync((char*)d_ws + WS_CTL, 0, CTL_ZERO_BYTES, stream) != hipSuccess) return;
    Args a{};
    for (int i = 0; i < 16; ++i) a.in[i] = (const float*)d_in[i];
    a.out = (float*)d_out; a.ws = (unsigned char*)d_ws;
    hipLaunchKernelGGL(fwd_kernel, dim3(grid), dim3(NTHREADS), LDS_BYTES, stream, a);
}
```
